# Optimizing an MI355X kernel written in HIP

```python
import math
import jax, jax.numpy as jnp
from jax import lax
import numpy as np

D_MODEL = 2048
BATCH = 4
SEQ = 2048
DEPTH = 4

N_A_LAYERS = DEPTH // 2
N_B_LAYERS = DEPTH - N_A_LAYERS
CHUNK = 128
A_GROUPS = 8
A_HALF = D_MODEL
HEAD_DIM = 64
N_HEADS = D_MODEL // HEAD_DIM
N_KV_HEADS = N_HEADS // 8
WINDOW = 128
BLOCK = WINDOW
N_BUCKETS = 32
MAX_DISTANCE = 128
D_FF = ((8 * D_MODEL // 3 + 255) // 256) * 256
RMS_EPS = 1e-5
NEG_INF = -1e30

kernel_name = "yoco_gmlp_swa_sink_hybrid"


def rmsnorm(x, g):
    x32 = x.astype(jnp.float32)
    y = x32 * lax.rsqrt(jnp.mean(x32 * x32, axis=-1, keepdims=True) + RMS_EPS)
    return (y * g.astype(jnp.float32)).astype(x.dtype)


def swiglu(x, w_gate, w_up, w_down):
    return (jax.nn.silu(x @ w_gate) * (x @ w_up)) @ w_down


def gmlp_mixer(xn, w_in, norm_v, w_s, b_s, w_out):
    B, S, _ = xn.shape
    n_chunks = S // CHUNK
    z = jax.nn.gelu(xn @ w_in)
    u, v = jnp.split(z, 2, axis=-1)
    v = rmsnorm(v, norm_v)
    v = v.reshape(B, n_chunks, CHUNK, A_GROUPS, A_HALF // A_GROUPS)
    w_causal = jnp.tril(w_s)
    s = jnp.einsum('gts,bcsgd->bctgd', w_causal, v) + b_s.T[None, None, :, :, None]
    gated = u * s.reshape(B, S, A_HALF)
    return gated @ w_out


def t5_bucket(dist):
    max_exact = N_BUCKETS // 2
    is_small = dist < max_exact
    d = jnp.maximum(dist, 1).astype(jnp.float32)
    large = max_exact + (jnp.log(d / max_exact) / math.log(MAX_DISTANCE / max_exact)
                         * (N_BUCKETS - max_exact)).astype(jnp.int32)
    large = jnp.minimum(large, N_BUCKETS - 1)
    return jnp.where(is_small, dist, large)


def banded_sink_attention(q, k, v, sinks, rel_bias):
    B, S = q.shape[0], q.shape[1]
    nb = S // BLOCK
    grp = N_HEADS // N_KV_HEADS
    qb = q.reshape(B, nb, BLOCK, N_KV_HEADS, grp, HEAD_DIM).astype(jnp.float32)

    def band(t):
        tp = jnp.pad(t, ((0, 0), (BLOCK, 0), (0, 0), (0, 0)))
        prev = tp[:, :S].reshape(B, nb, BLOCK, N_KV_HEADS, HEAD_DIM)
        cur = t.reshape(B, nb, BLOCK, N_KV_HEADS, HEAD_DIM)
        return jnp.concatenate([prev, cur], axis=2)

    kb = band(k).astype(jnp.float32)
    vb = band(v)
    scores = jnp.einsum('bcqhgd,bckhd->bchgqk', qb, kb) / math.sqrt(HEAD_DIM)

    dist = np.arange(BLOCK)[:, None] + BLOCK - np.arange(2 * BLOCK)[None, :]
    in_window = (dist >= 0) & (dist < WINDOW)
    bucket = t5_bucket(jnp.asarray(np.clip(dist, 0, None), dtype=jnp.int32))
    bias = rel_bias[bucket].astype(jnp.float32)
    bias = bias.transpose(2, 0, 1).reshape(N_KV_HEADS, grp, BLOCK, 2 * BLOCK)
    key_exists = (np.arange(nb)[:, None] * BLOCK - BLOCK + np.arange(2 * BLOCK)[None, :]) >= 0
    mask = in_window[None] & key_exists[:, None, :]
    mask = jnp.asarray(mask)[None, :, None, None]
    scores = jnp.where(mask, scores + bias, NEG_INF)

    sink = sinks.astype(jnp.float32).reshape(N_KV_HEADS, grp)[None, None, :, :, None, None]
    m = jnp.maximum(scores.max(axis=-1, keepdims=True), sink)
    p = jnp.exp(scores - m)
    denom = p.sum(axis=-1, keepdims=True) + jnp.exp(sink - m)
    probs = (p / denom).astype(v.dtype)
    out = jnp.einsum('bchgqk,bckhd->bcqhgd', probs, vb)
    return out.reshape(B, S, N_HEADS * HEAD_DIM)


def setup_inputs(seed: int = 0) -> dict:
    key = jax.random.key(seed)
    ks = jax.random.split(key, 24)
    f32 = jnp.float32
    out_scale = (2.0 * DEPTH) ** -0.5

    def nrm(k, shape, scale):
        return jax.random.normal(k, shape, f32) * scale

    kv_dim = 2 * N_KV_HEADS * HEAD_DIM
    return {
        "x": nrm(ks[0], (BATCH, SEQ, D_MODEL), 1.0),
        "mix_norm": 1.0 + nrm(ks[1], (DEPTH, D_MODEL), 0.1),
        "ffn_norm": 1.0 + nrm(ks[2], (DEPTH, D_MODEL), 0.1),
        "a_w_in": nrm(ks[3], (N_A_LAYERS, D_MODEL, 2 * A_HALF), D_MODEL ** -0.5),
        "a_norm_v": 1.0 + nrm(ks[4], (N_A_LAYERS, A_HALF), 0.1),
        "a_w_s": nrm(ks[5], (N_A_LAYERS, A_GROUPS, CHUNK, CHUNK), CHUNK ** -0.5),
        "a_b_s": 1.0 + nrm(ks[6], (N_A_LAYERS, A_GROUPS, CHUNK), 0.1),
        "a_w_out": nrm(ks[7], (N_A_LAYERS, A_HALF, D_MODEL), A_HALF ** -0.5 * out_scale),
        "kv_norm": 1.0 + nrm(ks[8], (D_MODEL,), 0.1),
        "w_kv": nrm(ks[9], (D_MODEL, kv_dim), D_MODEL ** -0.5),
        "b_kv": nrm(ks[10], (kv_dim,), 0.02),
        "b_w_q": nrm(ks[11], (N_B_LAYERS, D_MODEL, N_HEADS * HEAD_DIM), D_MODEL ** -0.5),
        "b_b_q": nrm(ks[12], (N_B_LAYERS, N_HEADS * HEAD_DIM), 0.02),
        "b_sinks": nrm(ks[13], (N_B_LAYERS, N_HEADS), 1.0),
        "b_w_o": nrm(ks[14], (N_B_LAYERS, N_HEADS * HEAD_DIM, D_MODEL), (N_HEADS * HEAD_DIM) ** -0.5 * out_scale),
        "b_b_o": nrm(ks[15], (N_B_LAYERS, D_MODEL), 0.02),
        "rel_bias": nrm(ks[16], (N_BUCKETS, N_HEADS), 0.5),
        "ffn_w_gate": nrm(ks[17], (DEPTH, D_MODEL, D_FF), D_MODEL ** -0.5),
        "ffn_w_up": nrm(ks[18], (DEPTH, D_MODEL, D_FF), D_MODEL ** -0.5),
        "ffn_w_down": nrm(ks[19], (DEPTH, D_FF, D_MODEL), D_FF ** -0.5 * out_scale),
        "final_norm": 1.0 + nrm(ks[20], (D_MODEL,), 0.1),
    }


def reference(x, mix_norm, ffn_norm, a_w_in, a_norm_v, a_w_s, a_b_s, a_w_out,
              kv_norm, w_kv, b_kv, b_w_q, b_b_q, b_sinks, b_w_o, b_b_o, rel_bias,
              ffn_w_gate, ffn_w_up, ffn_w_down, final_norm):
    B, S, _ = x.shape
    h = x
    k_shared = None
    v_shared = None
    for layer in range(DEPTH):
        xn = rmsnorm(h, mix_norm[layer])
        if layer < N_A_LAYERS:
            i = layer
            h = h + gmlp_mixer(xn, a_w_in[i], a_norm_v[i], a_w_s[i], a_b_s[i], a_w_out[i])
        else:
            i = layer - N_A_LAYERS
            q = (xn @ b_w_q[i] + b_b_q[i]).reshape(B, S, N_HEADS, HEAD_DIM)
            attn = banded_sink_attention(q, k_shared, v_shared, b_sinks[i], rel_bias)
            h = h + attn @ b_w_o[i] + b_b_o[i]
        h = h + swiglu(rmsnorm(h, ffn_norm[layer]), ffn_w_gate[layer], ffn_w_up[layer], ffn_w_down[layer])
        if layer == N_A_LAYERS - 1:
            kv = rmsnorm(h, kv_norm) @ w_kv + b_kv
            k_flat, v_flat = jnp.split(kv, 2, axis=-1)
            k_shared = k_flat.reshape(B, S, N_KV_HEADS, HEAD_DIM)
            v_shared = v_flat.reshape(B, S, N_KV_HEADS, HEAD_DIM)
    return rmsnorm(h, final_norm)
```

```cpp
#include <hip/hip_runtime.h>
#include <hip/hip_cooperative_groups.h>
#include <cstdio>
#include <cstdint>
namespace cg = cooperative_groups;
#ifndef MK_COOP
#define MK_COOP 1
#endif
#ifndef MK_SPLIT
#define MK_SPLIT 0
#endif
#ifndef MK_LAZY
#define MK_LAZY 1
#endif
#ifndef MK_RESID
#define MK_RESID 1
#endif
__device__ __forceinline__ int opaque_tid() { int t = threadIdx.x; asm volatile("" : "+v"(t)); return t; }
#ifndef MK_F16
#define MK_F16 0
#endif
typedef _Float16 h16x2_t __attribute__((ext_vector_type(2)));
typedef _Float16 h16x8_t __attribute__((ext_vector_type(8)));
typedef short s16x8_t __attribute__((ext_vector_type(8)));
typedef float f32x4_t __attribute__((ext_vector_type(4)));
__device__ __forceinline__ unsigned pkh16(float lo, float hi) { unsigned r; asm volatile("v_cvt_pk_f16_f32 %0, %1, %2" : "=v"(r) : "v"(lo), "v"(hi)); return r; }
__device__ __forceinline__ float unpkh_lo(unsigned w) { return (float)__builtin_bit_cast(h16x2_t, w)[0]; }
__device__ __forceinline__ float unpkh_hi(unsigned w) { return (float)__builtin_bit_cast(h16x2_t, w)[1]; }
#if MK_F16
__device__ __forceinline__ unsigned pk16(float lo, float hi) { unsigned r; asm volatile("v_cvt_pk_f16_f32 %0, %1, %2" : "=v"(r) : "v"(lo), "v"(hi)); return r; }
__device__ __forceinline__ float unpk_lo(unsigned w) { return (float)__builtin_bit_cast(h16x2_t, w)[0]; }
__device__ __forceinline__ float unpk_hi(unsigned w) { return (float)__builtin_bit_cast(h16x2_t, w)[1]; }
__device__ __forceinline__ f32x4_t mfma16(s16x8_t a, s16x8_t b, f32x4_t c, int, int, int) { return __builtin_amdgcn_mfma_f32_16x16x32_f16(__builtin_bit_cast(h16x8_t, a), __builtin_bit_cast(h16x8_t, b), c, 0, 0, 0); }
#else
__device__ __forceinline__ unsigned pk16(float lo, float hi) { unsigned r; asm volatile("v_cvt_pk_bf16_f32 %0, %1, %2" : "=v"(r) : "v"(lo), "v"(hi)); return r; }
__device__ __forceinline__ float unpk_lo(unsigned w) { return __uint_as_float(w << 16); }
__device__ __forceinline__ float unpk_hi(unsigned w) { return __uint_as_float(w & 0xffff0000u); }
__device__ __forceinline__ f32x4_t mfma16(s16x8_t a, s16x8_t b, f32x4_t c, int, int, int) { return __builtin_amdgcn_mfma_f32_16x16x32_bf16(a, b, c, 0, 0, 0); }
#endif
namespace pg8 {
#define PG8_LAS __attribute__((address_space(3)))
typedef unsigned short bf16_t;
typedef short bf16x8 __attribute__((ext_vector_type(8)));
typedef float f32x4 __attribute__((ext_vector_type(4)));
typedef unsigned u32x4 __attribute__((ext_vector_type(4)));
constexpr int BM = 256, BK = 64, HALF = 128, HTB = HALF * BK * 2  , STAGE_BYTES = 8 * HTB, NXCD = 8, WGM = 8;

__host__ __device__ __forceinline__ int lds_byte(int r, int c) { const int st = (r >> 4) * 2 + (c >> 5), rr = r & 15, cc = c & 31, ob = rr * 64 + cc * 2; return st * 1024 + (ob ^ (((ob >> 9) & 1) << 5)); }
__host__ __device__ __forceinline__ void stage_rc(int b, int& R, int& C) { const int st = b / 1024, sb = b % 1024, swz = sb ^ (((sb >> 9) & 1) << 5); R = (st >> 1) * 16 + swz / 64; C = (st & 1) * 32 + (swz % 64) / 2; }
__host__ __device__ __forceinline__ int perm32(int rho) { const int n = rho >> 4, i = rho & 15; return 8 * (i >> 2) + 4 * n + (i & 3); }

struct Unit { int pm, pn, kp, slot; };
struct Gemm { const bf16_t* A; const bf16_t* Bt; int M, N, K, nt; };

struct StaticOrder {
    int nM, nN, nwg, G, c, limit;
    __host__ __device__ void init(int M, int N, int G_, int c_) { nM = M / BM; nN = N / BM; nwg = nM * nN; G = G_; c = c_; limit = nwg; }
    __host__ __device__ void map(int L, Unit& u) const {
        int wgid = L; { const int q = nwg / NXCD, r = nwg % NXCD, xcd = wgid % NXCD, off = wgid / NXCD; wgid = (xcd < r ? xcd * (q + 1) : r * (q + 1) + (xcd - r) * q) + off; }
        const int nig = WGM * nN, gid = wgid / nig, fm = gid * WGM, gsz = (nM - fm) < WGM ? (nM - fm) : WGM;
        u.pm = fm + ((wgid % nig) % gsz); u.pn = (wgid % nig) / gsz; u.kp = 0; u.slot = 0;
    }
    __host__ __device__ bool next(int i, Unit& u) const {
        const long L = (long)i * G + c; if (L >= limit) return false;
        map((int)L, u); u.slot = i; return true;
    }
    __device__ __forceinline__ void a_ready(const Unit&) const {}
    __device__ __forceinline__ void done(const Unit&) const {}
};
struct SplitOrder {
    StaticOrder base; int L0, S, ntiles, kvmode, c;
    __device__ bool next(int i, Unit& u) const {
        if (i > 0) return false;
        const int slot = (c / (8 * S)) * 8 + (c & 7); if (slot >= ntiles) return false;
        if (kvmode) { u.pm = slot >> 1; u.pn = 8 + (slot & 1); } else base.map(L0 + slot, u);
        u.kp = (c >> 3) % S; u.slot = slot; return true;
    }
    __device__ __forceinline__ void a_ready(const Unit&) const {}
    __device__ __forceinline__ void done(const Unit&) const {}
};

__device__ __forceinline__ unsigned cvt_pk_bf16(float lo, float hi) { return pk16(lo, hi); }
typedef float f32x2 __attribute__((ext_vector_type(2)));
__device__ __forceinline__ float fast_sigmoid_mul(float x, float z) {   return x * __builtin_amdgcn_rcpf(1.0f + __builtin_amdgcn_exp2f(z * -1.4426950408889634f)); }
__device__ __forceinline__ float gelu_tanh(float x) { const float y2 = x * (1.5957691216057308f + 0.07135481627f * x * x); return fast_sigmoid_mul(x, y2); }
__device__ __forceinline__ float silu_f(float x) { return fast_sigmoid_mul(x, x); }
__device__ __forceinline__ void row_rstd(const float* stats, int row0, int fq, float (&rs)[2][4]) {
#pragma unroll
    for (int ai = 0; ai < 2; ++ai) {
        f32x4 pa[4], pb[4];
#pragma unroll
        for (int m = 0; m < 4; ++m) { const f32x4* p = (const f32x4*)(stats + (size_t)(row0 + ai * HALF + m * 16) * 32 + fq * 8); pa[m] = p[0]; pb[m] = p[1]; }
#pragma unroll
        for (int m = 0; m < 4; ++m) {
            const f32x4 a = pa[m], b = pb[m];
            float s = ((a[0] + a[1]) + (a[2] + a[3])) + ((b[0] + b[1]) + (b[2] + b[3]));
            s += __shfl_xor(s, 16); s += __shfl_xor(s, 32);
            rs[ai][m] = rsqrtf(s * (1.0f / 2048.0f) + 1e-5f);
        }
    }
}
__device__ __forceinline__ void row_rstd2(const float* stats, int row0, int fq, float (&rs)[2][4], float (&ms)[2][4]) {
#pragma unroll
    for (int ai = 0; ai < 2; ++ai) {
        f32x4 pa[4], pb[4];
#pragma unroll
        for (int m = 0; m < 4; ++m) { const f32x4* p = (const f32x4*)(stats + (size_t)(row0 + ai * HALF + m * 16) * 32 + fq * 8); pa[m] = p[0]; pb[m] = p[1]; }
#pragma unroll
        for (int m = 0; m < 4; ++m) {
            const f32x4 a = pa[m], b = pb[m];
            float s = ((a[0] + a[1]) + (a[2] + a[3])) + ((b[0] + b[1]) + (b[2] + b[3]));
            s += __shfl_xor(s, 16); s += __shfl_xor(s, 32);
            ms[ai][m] = s * (1.0f / 2048.0f) + 1e-5f; rs[ai][m] = rsqrtf(ms[ai][m]);
        }
    }
}
__device__ __forceinline__ void build_ms_table(PG8_LAS float* tab, const float* stats, const StaticOrder& S) {
    const int tid = opaque_tid(), row = tid >> 1, half = tid & 1;
    Unit u0, u; const bool any = S.next(0, u0); if (!any) return;
    f32x4 v[6][4];
#pragma unroll
    for (int i = 0; i < 6; ++i) {
        if (!S.next(i, u)) u = u0;
        const f32x4* p = (const f32x4*)(stats + (size_t)(u.pm * BM + row) * 32 + half * 16);
#pragma unroll
        for (int k = 0; k < 4; ++k) v[i][k] = p[k];
    }
#pragma unroll
    for (int i = 0; i < 6; ++i) {
        float sm = 0.f;
#pragma unroll
        for (int k = 0; k < 4; ++k) sm += (v[i][k][0] + v[i][k][1]) + (v[i][k][2] + v[i][k][3]);
        sm += __shfl_xor(sm, 1);
        if (half == 0) tab[i * BM + row] = sm * (1.0f / 2048.0f) + 1e-5f;
    }
}
__device__ __forceinline__ void tab_rstd(const PG8_LAS float* tab, const Unit& u, int wr, int fr, float (&rs)[2][4], float (&ms)[2][4]) {
#pragma unroll
    for (int ai = 0; ai < 2; ++ai)
#pragma unroll
        for (int m = 0; m < 4; ++m) { ms[ai][m] = tab[u.slot * BM + ai * HALF + wr * 64 + m * 16 + fr]; rs[ai][m] = rsqrtf(ms[ai][m]); }
}
__device__ __forceinline__ u32x4 pack8(const f32x4 v0, const f32x4 v1) { u32x4 w; w.x = cvt_pk_bf16(v0[0], v0[1]); w.y = cvt_pk_bf16(v0[2], v0[3]); w.z = cvt_pk_bf16(v1[0], v1[1]); w.w = cvt_pk_bf16(v1[2], v1[3]); return w; }
__device__ __forceinline__ float sq8(const f32x4 v0, const f32x4 v1) { return ((v0[0] * v0[0] + v0[1] * v0[1]) + (v0[2] * v0[2] + v0[3] * v0[3])) + ((v1[0] * v1[0] + v1[1] * v1[1]) + (v1[2] * v1[2] + v1[3] * v1[3])); }

struct EpiGeluUV {
    static constexpr bool PERM = true, AFTER_DRAIN = false;
    bf16_t* U; bf16_t* V; const float* hstats; float* vstats; const PG8_LAS float* tab;
    __device__ __forceinline__ void operator()(const f32x4 (&acc)[2][2][4][2], const Unit& u, int wr, int wc, int fr, int fq) const {
        const int row0 = u.pm * BM + wr * 64 + fr;
        float rs[2][4], ms_[2][4]; tab_rstd(tab, u, wr, fr, rs, ms_);
        const bool isv = u.pn >= 8; const int ct = isv ? u.pn - 8 : u.pn;
        bf16_t* base = isv ? V : U; const int col0 = ct * BM + wc * 32 + 8 * fq;
#pragma unroll
        for (int ai = 0; ai < 2; ++ai)
#pragma unroll
            for (int m = 0; m < 4; ++m) {
                const int row = row0 + ai * HALF + m * 16; const float r = rs[ai][m]; float ss = 0.f;
#pragma unroll
                for (int bj = 0; bj < 2; ++bj) {
                    f32x4 v0 = acc[ai][bj][m][0] * r, v1 = acc[ai][bj][m][1] * r;
#pragma unroll
                    for (int e = 0; e < 4; ++e) { v0[e] = gelu_tanh(v0[e]); v1[e] = gelu_tanh(v1[e]); }
                    ss += sq8(v0, v1);
                    *(u32x4*)(base + (size_t)row * 2048 + col0 + bj * HALF) = pack8(v0, v1);
                }
                if (isv) { ss += __shfl_xor(ss, 16); ss += __shfl_xor(ss, 32); if (fq == 0) vstats[(size_t)row * 32 + ct * 4 + wc] = ss; }
            }
    }
};
__device__ __forceinline__ void bf8_to_f32(const u32x4 w, f32x4& a, f32x4& b) {
    a[0] = unpk_lo(w.x); a[1] = unpk_hi(w.x); a[2] = unpk_lo(w.y); a[3] = unpk_hi(w.y);
    b[0] = unpk_lo(w.z); b[1] = unpk_hi(w.z); b[2] = unpk_lo(w.w); b[3] = unpk_hi(w.w);
}
__device__ __forceinline__ void h8_to_f32(const u32x4 w, f32x4& a, f32x4& b) {
    a[0] = unpkh_lo(w.x); a[1] = unpkh_hi(w.x); a[2] = unpkh_lo(w.y); a[3] = unpkh_hi(w.y);
    b[0] = unpkh_lo(w.z); b[1] = unpkh_hi(w.z); b[2] = unpkh_lo(w.w); b[3] = unpkh_hi(w.w);
}
struct EpiResid {
    static constexpr bool PERM = true, AFTER_DRAIN = false;
    float* H; bf16_t* HB; float* hstats; const float* bias; const float* Hin;
    bf16_t* LO;
    __device__ __forceinline__ void operator()(const f32x4 (&acc)[2][2][4][2], const Unit& u, int wr, int wc, int fr, int fq) const {
        const int row0 = u.pm * BM + wr * 64 + fr; const int col0 = u.pn * BM + wc * 32 + 8 * fq;
        f32x4 bv[2][2];
#pragma unroll
        for (int bj = 0; bj < 2; ++bj)
#pragma unroll
            for (int n = 0; n < 2; ++n) bv[bj][n] = bias ? *(const f32x4*)(bias + col0 + bj * HALF + 4 * n) : (f32x4){0.f, 0.f, 0.f, 0.f};
        if (Hin) {
            f32x4 hv[3][2][2];
#define RESID_LOAD(buf, g) do { _Pragma("unroll") for (int bj = 0; bj < 2; ++bj) { \
            const float* hp_ = Hin + (size_t)(row0 + ((g) >> 2) * HALF + ((g) & 3) * 16) * 2048 + col0 + bj * HALF; hv[buf][bj][0] = *(const f32x4*)hp_; hv[buf][bj][1] = *(const f32x4*)(hp_ + 4); } } while (0)
            RESID_LOAD(0, 0); RESID_LOAD(1, 1);
#pragma unroll
            for (int g = 0; g < 8; ++g) {
                const int ai = g >> 2, m = g & 3;
                if (g + 2 < 8) RESID_LOAD((g + 2) % 3, g + 2);
                const int row = row0 + ai * HALF + m * 16; float ss = 0.f;
#pragma unroll
                for (int bj = 0; bj < 2; ++bj) {
                    f32x4 h0 = hv[g % 3][bj][0], h1 = hv[g % 3][bj][1];
                    h0 = h0 + (acc[ai][bj][m][0] + bv[bj][0]); h1 = h1 + (acc[ai][bj][m][1] + bv[bj][1]);
                    store_h(row, col0 + bj * HALF, h0, h1);
                    ss += sq8(h0, h1);
                }
                ss += __shfl_xor(ss, 16); ss += __shfl_xor(ss, 32);
                if (fq == 0) hstats[(size_t)row * 32 + u.pn * 4 + wc] = ss;
            }
#undef RESID_LOAD
        } else {
            constexpr int NB = (MK_RESID == 2) ? 2 : 3;
            u32x4 hv[NB][2][2];
#define RESID_LOAD(buf, g) do { _Pragma("unroll") for (int bj = 0; bj < 2; ++bj) { \
            const size_t o_ = (size_t)(row0 + ((g) >> 2) * HALF + ((g) & 3) * 16) * 2048 + col0 + bj * HALF; hv[buf][bj][0] = *(const u32x4*)((MK_RESID == 3 ? LO : HB) + o_); if (MK_RESID == 2) hv[buf][bj][1] = *(const u32x4*)(LO + o_); } } while (0)
            RESID_LOAD(0, 0); if (NB == 3) RESID_LOAD(1, 1);
#pragma unroll
            for (int g = 0; g < 8; ++g) {
                const int ai = g >> 2, m = g & 3;
                if (g + NB - 1 < 8) RESID_LOAD((g + NB - 1) % NB, g + NB - 1);
                const int row = row0 + ai * HALF + m * 16; float ss = 0.f;
#pragma unroll
                for (int bj = 0; bj < 2; ++bj) {
                    f32x4 h0, h1; if (MK_RESID == 3) h8_to_f32(hv[g % NB][bj][0], h0, h1); else bf8_to_f32(hv[g % NB][bj][0], h0, h1);
                    if (MK_RESID == 2) { f32x4 l0, l1; bf8_to_f32(hv[g % NB][bj][1], l0, l1); h0 = h0 + l0; h1 = h1 + l1; }
                    h0 = h0 + (acc[ai][bj][m][0] + bv[bj][0]); h1 = h1 + (acc[ai][bj][m][1] + bv[bj][1]);
                    store_h(row, col0 + bj * HALF, h0, h1);
                    ss += sq8(h0, h1);
                }
                ss += __shfl_xor(ss, 16); ss += __shfl_xor(ss, 32);
                if (fq == 0) hstats[(size_t)row * 32 + u.pn * 4 + wc] = ss;
            }
#undef RESID_LOAD
        }
    }
    __device__ __forceinline__ void store_h(int row, int col, const f32x4 h0, const f32x4 h1) const {
        const size_t o = (size_t)row * 2048 + col;
        const u32x4 hi = pack8(h0, h1);
        *(u32x4*)(HB + o) = hi;
        if (MK_RESID == 0) { *(f32x4*)(H + o) = h0; *(f32x4*)(H + o + 4) = h1; }
        if (MK_RESID == 2) { f32x4 a, b; bf8_to_f32(hi, a, b); *(u32x4*)(LO + o) = pack8(h0 - a, h1 - b); }
        if (MK_RESID == 3) { u32x4 w; w.x = pkh16(h0[0], h0[1]); w.y = pkh16(h0[2], h0[3]); w.z = pkh16(h1[0], h1[1]); w.w = pkh16(h1[2], h1[3]); *(u32x4*)(LO + o) = w; }
    }
};
struct EpiSwiglu {
    static constexpr bool PERM = true, AFTER_DRAIN = false;
    bf16_t* ACT; const float* hstats; const PG8_LAS float* tab;
    __device__ __forceinline__ void operator()(const f32x4 (&acc)[2][2][4][2], const Unit& u, int wr, int wc, int fr, int fq) const { run(acc, u, wr, wc, fr, fq, 3, 3); }
    __device__ __forceinline__ void run(const f32x4 (&acc)[2][2][4][2], const Unit& u, int wr, int wc, int fr, int fq, int aimask, int  ) const {
        const int row0 = u.pm * BM + wr * 64 + fr; const int col0 = u.pn * HALF + wc * 32 + 8 * fq;
        float rs[2][4], ms[2][4]; if (tab) tab_rstd(tab, u, wr, fr, rs, ms); else row_rstd2(hstats, row0, fq, rs, ms);
#pragma unroll
        for (int ai = 0; ai < 2; ++ai) {
            if (!((aimask >> ai) & 1)) continue;
#pragma unroll
            for (int m = 0; m < 4; ++m) {
                const int row = row0 + ai * HALF + m * 16; const float rn = rs[ai][m] * -1.4426950408889634f, mq = ms[ai][m];
                f32x4 g0 = acc[ai][0][m][0], g1 = acc[ai][0][m][1]; const f32x4 u0 = acc[ai][1][m][0], u1 = acc[ai][1][m][1];
#pragma unroll
                for (int e = 0; e < 4; ++e) {
                    const float e0 = __builtin_amdgcn_exp2f(g0[e] * rn), e1 = __builtin_amdgcn_exp2f(g1[e] * rn);
                    g0[e] = (g0[e] * u0[e]) * __builtin_amdgcn_rcpf(__builtin_fmaf(e0, mq, mq)); g1[e] = (g1[e] * u1[e]) * __builtin_amdgcn_rcpf(__builtin_fmaf(e1, mq, mq));
                }
                *(u32x4*)(ACT + (size_t)row * 5632 + col0) = pack8(g0, g1);
            }
        }
    }
};
struct EpiQKV {
    static constexpr bool PERM = true, AFTER_DRAIN = false;
    bf16_t* Q; bf16_t* KV; const float* hstats; const float* bq; const float* bkv; float qscale; const PG8_LAS float* tab;
    __device__ __forceinline__ void operator()(const f32x4 (&acc)[2][2][4][2], const Unit& u, int wr, int wc, int fr, int fq) const { run(acc, u, wr, wc, fr, fq, 3, 3); }
    __device__ __forceinline__ void run(const f32x4 (&acc)[2][2][4][2], const Unit& u, int wr, int wc, int fr, int fq, int aimask, int bjmask) const {
        const int row0 = u.pm * BM + wr * 64 + fr;
        float rs[2][4], ms_[2][4]; if (tab) tab_rstd(tab, u, wr, fr, rs, ms_); else row_rstd(hstats, row0, fq, rs);
        const bool isq = u.pn < 8; const int ct = isq ? u.pn : u.pn - 8; const int ldc = isq ? 2048 : 512;
        bf16_t* base = isq ? Q : KV; const float* bias = isq ? bq : bkv; const float sc = isq ? qscale : 1.0f;
        const int col0 = ct * BM + wc * 32 + 8 * fq;
        f32x4 bv[2][2];
#pragma unroll
        for (int bj = 0; bj < 2; ++bj)
#pragma unroll
            for (int n = 0; n < 2; ++n) bv[bj][n] = *(const f32x4*)(bias + col0 + bj * HALF + 4 * n);
#pragma unroll
        for (int ai = 0; ai < 2; ++ai) {
            if (!((aimask >> ai) & 1)) continue;
#pragma unroll
            for (int m = 0; m < 4; ++m) {
                const int row = row0 + ai * HALF + m * 16; const float r = rs[ai][m];
#pragma unroll
                for (int bj = 0; bj < 2; ++bj) {
                    if (!((bjmask >> bj) & 1)) continue;
                    const f32x4 v0 = (acc[ai][bj][m][0] * r + bv[bj][0]) * sc, v1 = (acc[ai][bj][m][1] * r + bv[bj][1]) * sc;
                    *(u32x4*)(base + (size_t)row * ldc + col0 + bj * HALF) = pack8(v0, v1);
                }
            }
        }
    }
};

struct EpiStore {
    static constexpr bool PERM = true, AFTER_DRAIN = true;
    float* xbuf; unsigned* flags; int S;
    __device__ __forceinline__ void fused(f32x4 (&acc)[2][2][4][2], const Unit& u, int wr, int wc, int fr, int fq, PG8_LAS unsigned char* lds, int wid, int lane) const {
        typedef __attribute__((address_space(1))) unsigned gu32;
        const int tid = wid * 64 + lane;
        const f32x4* dst = (const f32x4*)xbuf + ((size_t)(u.slot * S + u.kp) * 32) * 512 + tid;
#pragma unroll
        for (int ai = 0; ai < 2; ++ai)
#pragma unroll
            for (int bj = 0; bj < 2; ++bj)
#pragma unroll
                for (int m = 0; m < 4; ++m)
#pragma unroll
                    for (int n = 0; n < 2; ++n) {
                        const f32x4 v = acc[ai][bj][m][n]; const f32x4* d = dst + (size_t)(((ai * 2 + bj) * 4 + m) * 2 + n) * 512;
                        asm volatile("global_store_dwordx4 %0, %1, off sc1" :: "v"(d), "v"(v) : "memory");
                    }
        asm volatile("s_waitcnt vmcnt(0)" ::: "memory");
        __syncthreads();
        if (tid == 0) __hip_atomic_fetch_add((gu32*)(flags + u.slot), 1u, __ATOMIC_RELAXED, __HIP_MEMORY_SCOPE_AGENT);
    }
};
template <class Inner> __device__ __forceinline__ void split_fixup(const Inner& inner, const float* xbuf, unsigned* flags, int S, const Unit& u) {
    typedef __attribute__((address_space(1))) unsigned gu32;
    const int tid = opaque_tid(), wid = tid >> 6, lane = tid & 63, wr = wid >> 2, wc = wid & 3, fr = lane & 15, fq = lane >> 4;
    if (tid == 0) {
        unsigned sp = 0;
        while (__hip_atomic_load((gu32*)(flags + u.slot), __ATOMIC_RELAXED, __HIP_MEMORY_SCOPE_AGENT) < (unsigned)S) { __builtin_amdgcn_s_sleep(2); if (++sp > (1u << 22)) break; }
        __builtin_amdgcn_fence(__ATOMIC_ACQUIRE, "agent");
        asm volatile("s_waitcnt vmcnt(0)" ::: "memory");
    }
    __syncthreads();
    const int aimask = (S == 2) ? (1 << u.kp) : (1 << (u.kp >> 1)), bjmask = (S == 2) ? 3 : (1 << (u.kp & 1));
    f32x4 acc[2][2][4][2];
#pragma unroll
    for (int ai = 0; ai < 2; ++ai)
#pragma unroll
        for (int bj = 0; bj < 2; ++bj)
#pragma unroll
            for (int m = 0; m < 4; ++m)
#pragma unroll
                for (int n = 0; n < 2; ++n) acc[ai][bj][m][n] = (f32x4){0.f, 0.f, 0.f, 0.f};
    for (int h = 0; h < S; ++h) {
        const f32x4* src = (const f32x4*)xbuf + ((size_t)(u.slot * S + h) * 32) * 512 + tid;
#pragma unroll
        for (int ai = 0; ai < 2; ++ai) {
            if (!((aimask >> ai) & 1)) continue;
#pragma unroll
            for (int bj = 0; bj < 2; ++bj) {
                if (!((bjmask >> bj) & 1)) continue;
                f32x4 t[4][2];
#pragma unroll
                for (int m = 0; m < 4; ++m)
#pragma unroll
                    for (int n = 0; n < 2; ++n) t[m][n] = src[(size_t)(((ai * 2 + bj) * 4 + m) * 2 + n) * 512];
#pragma unroll
                for (int m = 0; m < 4; ++m)
#pragma unroll
                    for (int n = 0; n < 2; ++n) acc[ai][bj][m][n] = acc[ai][bj][m][n] + t[m][n];
            }
        }
    }
    inner.run(acc, u, wr, wc, fr, fq, aimask, bjmask);
}

template <class Epi, class Sched, bool ALIGN_EPI = false, bool SP2 = false>
__device__ __forceinline__ void gemm_phase(PG8_LAS unsigned char* lds, const Gemm g, const Sched& S, const Epi& E) {
    const int tid = opaque_tid(), wid = __builtin_amdgcn_readfirstlane(tid >> 6), lane = tid & 63, wr = wid >> 2, wc = wid & 3, fr = lane & 15, fq = lane >> 4;
    const int K = g.K, nt = g.nt;
    unsigned voffA[2], voffB[2];
#pragma unroll
    for (int i = 0; i < 2; ++i) { int R, C; stage_rc(tid * 16 + i * 8192, R, C); const int Rb = Epi::PERM ? ((R & ~31) + perm32(R & 31)) : R;
        voffA[i] = (unsigned)(R * K + C) * 2u; voffB[i] = (unsigned)(Rb * K + C) * 2u; }
    const size_t kstep = (size_t)(BK * 2);
    const size_t hstep = (size_t)HALF * K * 2;
    const size_t tstep = 2 * hstep;
    const unsigned ldsw = (unsigned)wid * 1024u;
    const int aoff = lds_byte(wr * 64 + fr, fq * 8), boff = lds_byte(wc * 32 + fr, fq * 8);
#define PG8_SA(b, h) (((b) * 2 + (h)) * HTB)
#define PG8_SB(b, h) ((4 + (b) * 2 + (h)) * HTB)
#define PG8_STAGE(bufoff, gbase, voff) do { _Pragma("unroll") for (int _i = 0; _i < 2; ++_i) \
        __builtin_amdgcn_global_load_lds((const unsigned*)((const char*)(gbase) + (voff)[_i]), (PG8_LAS unsigned*)(lds + (bufoff) + ldsw + _i * 8192), 16, 0, 0); } while (0)
#define PG8_LDA(dst, b, h) do { _Pragma("unroll") for (int m = 0; m < 4; ++m) _Pragma("unroll") for (int k = 0; k < 2; ++k) dst[m][k] = *(const PG8_LAS bf16x8*)(lds + PG8_SA(b, h) + aoff + m * 2048 + k * 1024); } while (0)
#define PG8_LDB(dst, b, h) do { _Pragma("unroll") for (int n = 0; n < 2; ++n) _Pragma("unroll") for (int k = 0; k < 2; ++k) dst[n][k] = *(const PG8_LAS bf16x8*)(lds + PG8_SB(b, h) + boff + n * 2048 + k * 1024); } while (0)
#define PG8_MMA(ai, bj, At, Bt) do { __builtin_amdgcn_s_setprio(1); _Pragma("unroll") for (int m = 0; m < 4; ++m) _Pragma("unroll") for (int n = 0; n < 2; ++n) _Pragma("unroll") for (int k = 0; k < 2; ++k) \
        acc[ai][bj][m][n] = mfma16(Bt[n][k], At[m][k], acc[ai][bj][m][n], 0, 0, 0); __builtin_amdgcn_s_setprio(0); } while (0)
#define PG8_WAIT_V(n) asm volatile("s_waitcnt vmcnt(" #n ")" ::: "memory")
#define PG8_WAIT_L(n) asm volatile("s_waitcnt lgkmcnt(" #n ")" ::: "memory")
#define PG8_BAR __builtin_amdgcn_s_barrier()
#define PG8_SCHED __builtin_amdgcn_sched_barrier(0)
    Unit cur, nxt; int ui = 0;
    if (!S.next(0, cur)) return;
    f32x4 acc[2][2][4][2];
#pragma unroll
    for (int a = 0; a < 2; ++a)
#pragma unroll
        for (int b = 0; b < 2; ++b)
#pragma unroll
            for (int m = 0; m < 4; ++m)
#pragma unroll
                for (int n = 0; n < 2; ++n) acc[a][b][m][n] = (f32x4){0.f, 0.f, 0.f, 0.f};
    bf16x8 At[4][2], B0[2][2], B1[2][2];
    const size_t kpstep = (size_t)nt * kstep;
    const char* cA = (const char*)g.A + (size_t)cur.pm * tstep + (size_t)cur.kp * kpstep; const char* cB = (const char*)g.Bt + (size_t)cur.pn * tstep + (size_t)cur.kp * kpstep;
    S.a_ready(cur);
    if constexpr (SP2) {
        PG8_STAGE(PG8_SB(0, 0), cB, voffB); PG8_STAGE(PG8_SB(0, 1), cB + hstep, voffB); PG8_STAGE(PG8_SA(0, 0), cA, voffA); PG8_STAGE(PG8_SA(0, 1), cA + hstep, voffA);
        if (wr == 1) PG8_BAR;
        PG8_WAIT_V(2); PG8_BAR;
        PG8_STAGE(PG8_SB(1, 0), cB + kstep, voffB); PG8_STAGE(PG8_SA(1, 0), cA + kstep, voffA); PG8_STAGE(PG8_SB(1, 1), cB + hstep + kstep, voffB);
        PG8_WAIT_V(6); PG8_BAR;
    } else {
        PG8_STAGE(PG8_SB(0, 0), cB, voffB); PG8_STAGE(PG8_SA(0, 0), cA, voffA); PG8_STAGE(PG8_SB(0, 1), cB + hstep, voffB); PG8_STAGE(PG8_SA(0, 1), cA + hstep, voffA);
        if (wr == 1) PG8_BAR;
        PG8_WAIT_V(4); PG8_BAR;
        PG8_STAGE(PG8_SB(1, 0), cB + kstep, voffB); PG8_STAGE(PG8_SA(1, 0), cA + kstep, voffA); PG8_STAGE(PG8_SB(1, 1), cB + hstep + kstep, voffB);
        PG8_WAIT_V(6); PG8_BAR;
    }
    for (;;) {
        const bool has_next = S.next(ui + 1, nxt);
        const char* nA = has_next ? (const char*)g.A + (size_t)nxt.pm * tstep + (size_t)nxt.kp * kpstep : cA; const char* nB = has_next ? (const char*)g.Bt + (size_t)nxt.pn * tstep + (size_t)nxt.kp * kpstep : cB;
        for (int t = 0; t < nt; t += 2) {
            const bool last = (t == nt - 2);
            const char* a1 = cA + (size_t)(t + 1) * kstep;
            const char* a2 = last ? nA : cA + (size_t)(t + 2) * kstep; const char* b2 = last ? nB : cB + (size_t)(t + 2) * kstep;
            const char* a3 = a2 + kstep; const char* b3 = b2 + kstep;
            if (last && has_next) S.a_ready(nxt);
            if constexpr (SP2) {
            PG8_LDB(B0, 0, 0); PG8_LDB(B1, 0, 1); PG8_SCHED; PG8_LDA(At, 0, 0); PG8_STAGE(PG8_SA(1, 1), a1 + hstep, voffA);
            PG8_WAIT_V(8); PG8_WAIT_L(0); PG8_BAR; PG8_MMA(0, 0, At, B0); PG8_MMA(0, 1, At, B1); PG8_BAR; PG8_SCHED;
            PG8_LDA(At, 0, 1); PG8_STAGE(PG8_SB(0, 0), b2, voffB); PG8_STAGE(PG8_SB(0, 1), b2 + hstep, voffB); PG8_STAGE(PG8_SA(0, 0), a2, voffA);
            PG8_WAIT_V(8); PG8_WAIT_L(0); PG8_BAR; PG8_MMA(1, 0, At, B0); PG8_MMA(1, 1, At, B1); PG8_BAR; PG8_SCHED;
            PG8_LDB(B0, 1, 0); PG8_LDB(B1, 1, 1); PG8_SCHED; PG8_LDA(At, 1, 0); PG8_STAGE(PG8_SA(0, 1), a2 + hstep, voffA);
            PG8_WAIT_V(8); PG8_WAIT_L(0); PG8_BAR; PG8_MMA(0, 0, At, B0); PG8_MMA(0, 1, At, B1); PG8_BAR; PG8_SCHED;
            PG8_LDA(At, 1, 1); PG8_STAGE(PG8_SB(1, 0), b3, voffB); PG8_STAGE(PG8_SB(1, 1), b3 + hstep, voffB); PG8_STAGE(PG8_SA(1, 0), a3, voffA);
            PG8_WAIT_V(8); PG8_WAIT_L(0); PG8_BAR; PG8_MMA(1, 0, At, B0); PG8_MMA(1, 1, At, B1); PG8_BAR; PG8_SCHED;
            } else {
            PG8_LDB(B0, 0, 0); PG8_SCHED; PG8_LDA(At, 0, 0); PG8_STAGE(PG8_SA(1, 1), a1 + hstep, voffA);
            PG8_WAIT_L(8); PG8_BAR; PG8_WAIT_L(0); PG8_MMA(0, 0, At, B0); PG8_BAR; PG8_SCHED;
            PG8_LDB(B1, 0, 1); PG8_STAGE(PG8_SB(0, 0), b2, voffB);
            PG8_BAR; PG8_WAIT_L(0); PG8_MMA(0, 1, At, B1); PG8_BAR;
            PG8_LDA(At, 0, 1); PG8_STAGE(PG8_SA(0, 0), a2, voffA);
            PG8_BAR; PG8_WAIT_L(0); PG8_MMA(1, 0, At, B0); PG8_BAR; PG8_SCHED;
            PG8_STAGE(PG8_SB(0, 1), b2 + hstep, voffB);
            PG8_WAIT_V(6); PG8_BAR; PG8_MMA(1, 1, At, B1); PG8_BAR;
            PG8_LDB(B0, 1, 0); PG8_SCHED; PG8_LDA(At, 1, 0); PG8_STAGE(PG8_SA(0, 1), a2 + hstep, voffA);
            PG8_WAIT_L(8); PG8_BAR; PG8_WAIT_L(0); PG8_MMA(0, 0, At, B0); PG8_BAR; PG8_SCHED;
            PG8_LDB(B1, 1, 1); PG8_STAGE(PG8_SB(1, 0), b3, voffB);
            PG8_BAR; PG8_WAIT_L(0); PG8_MMA(0, 1, At, B1); PG8_BAR;
            PG8_LDA(At, 1, 1); PG8_STAGE(PG8_SA(1, 0), a3, voffA);
            PG8_BAR; PG8_WAIT_L(0); PG8_MMA(1, 0, At, B0); PG8_BAR; PG8_SCHED;
            PG8_STAGE(PG8_SB(1, 1), b3 + hstep, voffB);
            PG8_WAIT_V(6); PG8_BAR; PG8_MMA(1, 1, At, B1); PG8_BAR;
            }
        }
        if constexpr (ALIGN_EPI) { if (wr == 0) PG8_BAR; }
        if constexpr (!Epi::AFTER_DRAIN) { E(acc, cur, wr, wc, fr, fq); S.done(cur); }
        if (!has_next) break;
#pragma unroll
        for (int a = 0; a < 2; ++a)
#pragma unroll
            for (int b = 0; b < 2; ++b)
#pragma unroll
                for (int m = 0; m < 4; ++m)
#pragma unroll
                    for (int n = 0; n < 2; ++n) acc[a][b][m][n] = (f32x4){0.f, 0.f, 0.f, 0.f};
        cur = nxt; cA = nA; cB = nB; ++ui;
        if constexpr (ALIGN_EPI) { if (wr == 1) PG8_BAR; }
    }
    PG8_WAIT_V(0);
    if constexpr (!ALIGN_EPI) { if (wr == 0) PG8_BAR; }
    PG8_BAR;
    if constexpr (Epi::AFTER_DRAIN) { E.fused(acc, cur, wr, wc, fr, fq, lds, wid, lane); S.done(cur); }
#undef PG8_SA
#undef PG8_SB
#undef PG8_STAGE
#undef PG8_LDA
#undef PG8_LDB
#undef PG8_MMA
#undef PG8_WAIT_V
#undef PG8_WAIT_L
#undef PG8_BAR
#undef PG8_SCHED
}
}

constexpr int M = 8192, DM = 2048, SEQ = 2048, DFF = 5632, NH = 32, NKV = 4, HD = 64;
constexpr int NWAVES = 8, NTHREADS = 512;
constexpr size_t MiB = 1u << 20;
constexpr size_t WS_HSTAT = 1 * MiB, WS_VSTAT = 2 * MiB;
constexpr size_t WS_AIN = 4 * MiB;
constexpr size_t WS_AOUT = 36 * MiB;
constexpr size_t WS_FUP = 52 * MiB;
constexpr size_t WS_FDN = 228 * MiB;
constexpr size_t WS_Q0 = 316 * MiB;
constexpr size_t WS_Q1 = 326 * MiB;
constexpr size_t WS_WO = 334 * MiB;
constexpr size_t WS_HB = 350 * MiB;
constexpr size_t WS_B1 = 382 * MiB;
constexpr size_t WS_B2 = 414 * MiB;
constexpr size_t WS_B3 = 446 * MiB;
constexpr size_t WS_ACT = 478 * MiB;
constexpr size_t WS_KV = 566 * MiB;
constexpr size_t WS_LO = 638 * MiB;
constexpr size_t WS_XB = 574 * MiB;
constexpr size_t WS_END = 670 * MiB;
constexpr size_t CTL_FLAGS = 32768;
constexpr int LDS_BYTES = 147456;
constexpr int N_PHASES = 22;
constexpr int TAB_OFF = 131072;
constexpr int MISC_OFF = 140 * 1024;
constexpr size_t CTL_ZERO_BYTES = 65536;

#define LAS __attribute__((address_space(3)))
#define KAS __attribute__((address_space(4)))
typedef const float* cfp;
typedef const KAS cfp* kin_t;
typedef unsigned short bf16;
typedef unsigned v4u __attribute__((ext_vector_type(4)));
typedef unsigned v2u __attribute__((ext_vector_type(2)));
typedef float f32x4 __attribute__((ext_vector_type(4)));
typedef short bf16x8 __attribute__((ext_vector_type(8)));
#define LDS_WAIT() asm volatile("s_waitcnt lgkmcnt(0)" ::: "memory")
__device__ __forceinline__ unsigned pk2(float lo, float hi) { return pg8::cvt_pk_bf16(lo, hi); }
__device__ __forceinline__ float bf2f(unsigned short b) { return __uint_as_float((unsigned)b << 16); }
__device__ __forceinline__ float wave_sum(float v) {
#pragma unroll
    for (int o = 1; o < 64; o <<= 1) v += __shfl_xor(v, o);
    return v;
}

#define XB_TMO      128
#define XB_XCNT(j)  (256  + 64 * (j))
#define XB_XSUB(j)  (1280 + 64 * (j))
#define XB_XGEN(j)  (2304 + 64 * (j))
#define XB_TOP      3328
#define XB_TOPGEN   3392
#define XCD_BAR_WORDS 3456
#define XB_SPIN_CAP (1u << 18)

__device__ __forceinline__ unsigned xb_ld(unsigned* p)              { return __hip_atomic_load(p, __ATOMIC_RELAXED, __HIP_MEMORY_SCOPE_AGENT); }
__device__ __forceinline__ unsigned xb_add(unsigned* p, unsigned v) { return __hip_atomic_fetch_add(p, v, __ATOMIC_RELAXED, __HIP_MEMORY_SCOPE_AGENT); }
__device__ __forceinline__ unsigned xb_xcc_id() { return (unsigned)__builtin_amdgcn_s_getreg((3 << 11) | 20) & 0xFu; }
#define XB_SPIN(cond, bar) do { unsigned _sp = 0; while (cond) { __builtin_amdgcn_s_sleep(1); \
    if ((++_sp & 255u) == 0u) { if (xb_ld(&(bar)[XB_TMO])) break; if (_sp > XB_SPIN_CAP) { atomicAdd(&(bar)[XB_TMO], 1u); break; } } } } while (0)

struct XcdBarrier {
    unsigned* bar; unsigned x;
    volatile LAS unsigned* st;
};

__device__ __forceinline__ XcdBarrier xcd_barrier_post(unsigned* bar, volatile LAS unsigned* st) {
    XcdBarrier b; b.bar = bar; b.x = xb_xcc_id(); b.st = st;
    if (threadIdx.x == 0) (void)xb_add(&bar[XB_XCNT(b.x)], 1u);
    return b;
}
__device__ __forceinline__ void xcd_barrier_complete(unsigned* bar, unsigned x, unsigned& nloc, unsigned& nx) {
    const unsigned G = gridDim.x * gridDim.y * gridDim.z;
    unsigned sum, cnt, mine, sp = 0u;
    for (;;) {
        sum = 0u; cnt = 0u; mine = 0u;
#pragma unroll
        for (unsigned j = 0; j < 16; ++j) { const unsigned c = xb_ld(&bar[XB_XCNT(j)]); sum += c; cnt += (c > 0u) ? 1u : 0u; mine = (j == x) ? c : mine; }
        if (sum == G) break;
        __builtin_amdgcn_s_sleep(1);
        if ((++sp & 255u) == 0u) { if (xb_ld(&bar[XB_TMO])) break; if (sp > XB_SPIN_CAP) { atomicAdd(&bar[XB_TMO], 1u); break; } }
    }
    nloc = mine > 0u ? mine : 1u; nx = cnt > 0u ? cnt : 1u;
}

__device__ __forceinline__ void xcd_barrier(const XcdBarrier& b) {
    asm volatile("s_waitcnt vmcnt(0)" ::: "memory");
    __syncthreads();
    if (threadIdx.x == 0) {
        unsigned* bar = b.bar;
        __builtin_amdgcn_s_waitcnt(0);
        unsigned nloc = b.st[0], nx = b.st[1];
        if (nloc == 0u) { xcd_barrier_complete(bar, b.x, nloc, nx); b.st[0] = nloc; b.st[1] = nx; }
        const unsigned old = xb_add(&bar[XB_XSUB(b.x)], 1u);
        const unsigned gen = old / nloc;
        if (old + 1u == (gen + 1u) * nloc) {
            __builtin_amdgcn_fence(__ATOMIC_RELEASE, "agent");
            asm volatile("s_waitcnt vmcnt(0)" ::: "memory");
            const unsigned og = xb_add(&bar[XB_TOP], 1u);
            const unsigned tg = og / nx;
            if (og + 1u == (tg + 1u) * nx) xb_add(&bar[XB_TOPGEN], 1u);
            else XB_SPIN(xb_ld(&bar[XB_TOPGEN]) == tg, bar);
            __builtin_amdgcn_fence(__ATOMIC_ACQUIRE, "agent");
            xb_add(&bar[XB_XGEN(b.x)], 1u);
            asm volatile("s_waitcnt vmcnt(0)" ::: "memory");
        } else {
            XB_SPIN(xb_ld(&bar[XB_XGEN(b.x)]) == gen, bar);
            __builtin_amdgcn_fence(__ATOMIC_ACQUIRE, "agent");
            asm volatile("s_waitcnt vmcnt(0)" ::: "memory");
        }
    }
    __syncthreads();
}

__device__ __forceinline__ void tr_item(const float* W, int K, int N, bf16* WT, int k0, int n0, int drow0, const float* gain, LAS float* scr, int lane) {
    const int lr = lane >> 4, lc = 4 * (lane & 15);
    f32x4 wv[16];
#pragma unroll
    for (int i = 0; i < 16; ++i) wv[i] = *(const f32x4*)(W + (size_t)(k0 + 4 * i + lr) * N + n0 + lc);
#pragma unroll
    for (int i = 0; i < 16; ++i) { LAS float* d = scr + (4 * i + lr) * 65 + lc; d[0] = wv[i][0]; d[1] = wv[i][1]; d[2] = wv[i][2]; d[3] = wv[i][3]; }
    LDS_WAIT();
    const int c = lane & 7;
    f32x4 g0 = {1.f, 1.f, 1.f, 1.f}, g1 = {1.f, 1.f, 1.f, 1.f};
    if (gain) { g0 = *(const f32x4*)(gain + k0 + 8 * c); g1 = *(const f32x4*)(gain + k0 + 8 * c + 4); }
#pragma unroll
    for (int j = 0; j < 8; ++j) {
        const int n = (lane >> 3) + 8 * j; const LAS float* s = scr + (8 * c) * 65 + n;
        v4u o; o.x = pk2(s[0 * 65] * g0[0], s[1 * 65] * g0[1]); o.y = pk2(s[2 * 65] * g0[2], s[3 * 65] * g0[3]);
        o.z = pk2(s[4 * 65] * g1[0], s[5 * 65] * g1[1]); o.w = pk2(s[6 * 65] * g1[2], s[7 * 65] * g1[3]);
        *(v4u*)(WT + (size_t)(drow0 + n) * K + k0 + 8 * c) = o;
    }
    LDS_WAIT();
}
__device__ __forceinline__ void tr_mat(const float* W, int K, int N, bf16* WT, int item, const float* gain, int mode  , LAS float* scr, int lane) {
    const int nblk = N >> 6; const int kb = item / nblk, nb = item - kb * nblk; const int n0 = nb * 64;
    int drow0 = n0;
    if (mode) drow0 = (n0 >> 7) * 256 + (n0 & 127) + (mode == 2 ? 128 : 0);
    tr_item(W, K, N, WT, kb * 64, n0, drow0, gain, scr, lane);
}

__device__ __forceinline__ int mat_items(int id) { return id < 2 ? 32 * 64 : id < 4 ? 32 * 32 : id < 16 ? 32 * 88 : id == 16 ? 32 * 8 : 32 * 32; }
__device__ __forceinline__ void convert_item(int id, int r, kin_t in, unsigned char* ws, LAS float* scr, int lane) {
    const float* mixn = in[1]; const float* ffnn = in[2];
    if (id < 2) tr_mat(in[3] + (size_t)id * DM * 4096, DM, 4096, (bf16*)(ws + WS_AIN + (size_t)id * 16 * MiB), r, mixn + id * DM, 0, scr, lane);
    else if (id < 4) tr_mat(in[7] + (size_t)(id - 2) * DM * DM, DM, DM, (bf16*)(ws + WS_AOUT + (size_t)(id - 2) * 8 * MiB), r, nullptr, 0, scr, lane);
    else if (id < 8) tr_mat(in[17] + (size_t)(id - 4) * DM * DFF, DM, DFF, (bf16*)(ws + WS_FUP + (size_t)(id - 4) * 44 * MiB), r, ffnn + (id - 4) * DM, 1, scr, lane);
    else if (id < 12) tr_mat(in[18] + (size_t)(id - 8) * DM * DFF, DM, DFF, (bf16*)(ws + WS_FUP + (size_t)(id - 8) * 44 * MiB), r, ffnn + (id - 8) * DM, 2, scr, lane);
    else if (id < 16) tr_mat(in[19] + (size_t)(id - 12) * DFF * DM, DFF, DM, (bf16*)(ws + WS_FDN + (size_t)(id - 12) * 22 * MiB), r, nullptr, 0, scr, lane);
    else if (id == 16) tr_mat(in[9], DM, 512, (bf16*)(ws + WS_Q0) + (size_t)2048 * DM, r, in[8], 0, scr, lane);
    else if (id < 19) tr_mat(in[11] + (size_t)(id - 17) * DM * DM, DM, DM, (bf16*)(ws + (id == 18 ? WS_Q1 : WS_Q0)), r, mixn + (2 + id - 17) * DM, 0, scr, lane);
    else tr_mat(in[14] + (size_t)(id - 19) * DM * DM, DM, DM, (bf16*)(ws + WS_WO + (size_t)(id - 19) * 8 * MiB), r, nullptr, 0, scr, lane);
}
__device__ __forceinline__ void convert_set(LAS unsigned char* lds, kin_t in, unsigned char* ws, unsigned long long set, int widx, int nworkers) {
    const int tid = opaque_tid(), lane = tid & 63, wave = __builtin_amdgcn_readfirstlane(tid >> 6);
    LAS float* scr = (LAS float*)(lds + wave * 16640);
    int base = 0;
    for (; (set & 31ull) != 31ull; set >>= 5) {
        const int id = (int)(set & 31ull), n = mat_items(id);
        int start = (widx - base) % nworkers; if (start < 0) start += nworkers;
        for (int r = start; r < n; r += nworkers) convert_item(id, r, in, ws, scr, lane);
        base += n;
    }
}
#define MSET1(a) ((unsigned long long)(a) | (31ull << 5))
#define MSET3(a, b, c) ((unsigned long long)(a) | ((unsigned long long)(b) << 5) | ((unsigned long long)(c) << 10) | (31ull << 15))
#define MSET4(a, b, c, d) ((unsigned long long)(a) | ((unsigned long long)(b) << 5) | ((unsigned long long)(c) << 10) | ((unsigned long long)(d) << 15) | (31ull << 20))
#define MSET7(a, b, c, d, e, f, g) ((unsigned long long)(a) | ((unsigned long long)(b) << 5) | ((unsigned long long)(c) << 10) | ((unsigned long long)(d) << 15) | ((unsigned long long)(e) << 20) | ((unsigned long long)(f) << 25) | ((unsigned long long)(g) << 30) | (31ull << 35))
#if MK_LAZY
#define MSET5(a, b, c, d, e) ((unsigned long long)(a) | ((unsigned long long)(b) << 5) | ((unsigned long long)(c) << 10) | ((unsigned long long)(d) << 15) | ((unsigned long long)(e) << 20) | (31ull << 25))
constexpr unsigned long long SET_PRO = MSET4(0, 2, 4, 8);
constexpr unsigned long long SET_PH4 = MSET5(12, 1, 3, 9, 5), SET_PH9 = MSET4(13, 17, 16, 19), SET_PH11 = MSET3(6, 10, 7), SET_PH14 = MSET4(14, 18, 20, 11), SET_PH19 = MSET1(15);
#endif
__device__ __forceinline__ void tail_convert(LAS unsigned char* lds, kin_t in, unsigned char* ws, unsigned long long set, int nunits, int blk, int nblk) {
    const int nfull = nunits % nblk;
    if (blk < nfull) return;
    const int wave = __builtin_amdgcn_readfirstlane(threadIdx.x >> 6);
    convert_set(lds, in, ws, set, (blk - nfull) * NWAVES + wave, (nblk - nfull) * NWAVES);
}

__device__ __forceinline__ void prologue_phase(LAS unsigned char* lds, kin_t in, float* H, unsigned char* ws, int blk, int nblk) {
    const int tid = opaque_tid(), lane = tid & 63, wave = __builtin_amdgcn_readfirstlane(tid >> 6);
    const int gw = blk * NWAVES + wave, NGW = nblk * NWAVES;
#if MK_LAZY
    convert_set(lds, in, ws, SET_PRO, gw, NGW);
#else
    for (int id = 0; id < 21; ++id) convert_set(lds, in, ws, MSET1(id), gw, NGW);
#endif
    const float* x = in[0]; bf16* HB = (bf16*)(ws + WS_HB); float* hstats = (float*)(ws + WS_HSTAT);
    for (int m = gw; m < M; m += NGW) {
        const f32x4* xr = (const f32x4*)(x + (size_t)m * DM) + lane;
        v2u* hb = (v2u*)(HB + (size_t)m * DM) + lane;
        f32x4 v[8]; float s = 0.f;
#pragma unroll
        for (int j = 0; j < 8; ++j) { v[j] = xr[64 * j]; s += (v[j][0] * v[j][0] + v[j][1] * v[j][1]) + (v[j][2] * v[j][2] + v[j][3] * v[j][3]); }
        const float tot = wave_sum(s);
#pragma unroll
        for (int j = 0; j < 8; ++j) { v2u o; o.x = pk2(v[j][0], v[j][1]); o.y = pk2(v[j][2], v[j][3]); hb[64 * j] = o;
            if (MK_RESID == 3) { v2u l; l.x = pkh16(v[j][0], v[j][1]); l.y = pkh16(v[j][2], v[j][3]); ((v2u*)((bf16*)(ws + WS_LO) + (size_t)m * DM))[lane + 64 * j] = l; }
            if (MK_RESID == 2) { v2u l; l.x = pk2(v[j][0] - unpk_lo(o.x), v[j][1] - unpk_hi(o.x)); l.y = pk2(v[j][2] - unpk_lo(o.y), v[j][3] - unpk_hi(o.y)); ((v2u*)((bf16*)(ws + WS_LO) + (size_t)m * DM))[lane + 64 * j] = l; } }
        if (lane < 32) hstats[(size_t)m * 32 + lane] = (lane == 0) ? tot : 0.f;
    }
}

__device__ __forceinline__ void final_phase(float* H, const bf16* HB, const bf16* LO, const float* hstats, const float* fn, int blk, int nblk) {
    const int tid = opaque_tid(), lane = tid & 63, wave = tid >> 6;
    const int gw = blk * NWAVES + wave, NGW = nblk * NWAVES;
    if (MK_RESID == 0) {
        f32x4 g[8];
#pragma unroll
        for (int j = 0; j < 8; ++j) g[j] = ((const f32x4*)fn)[lane + 64 * j];
        for (int m = gw; m < M; m += NGW) {
            const float p = (lane < 32) ? hstats[(size_t)m * 32 + lane] : 0.f;
            const float rstd = rsqrtf(wave_sum(p) * (1.0f / 2048.0f) + 1e-5f);
            f32x4* hr = (f32x4*)(H + (size_t)m * DM) + lane;
#pragma unroll
            for (int j = 0; j < 8; ++j) { f32x4 v = hr[64 * j]; v = v * rstd * g[j]; hr[64 * j] = v; }
        }
    } else {
        f32x4 g[4][2];
#pragma unroll
        for (int j = 0; j < 4; ++j) { g[j][0] = ((const f32x4*)fn)[2 * (lane + 64 * j)]; g[j][1] = ((const f32x4*)fn)[2 * (lane + 64 * j) + 1]; }
        for (int m = gw; m < M; m += NGW) {
            v4u hb[4], lo[4];
#pragma unroll
            for (int j = 0; j < 4; ++j) { hb[j] = ((const v4u*)((MK_RESID == 3 ? LO : HB) + (size_t)m * DM))[lane + 64 * j]; if (MK_RESID == 2) lo[j] = ((const v4u*)(LO + (size_t)m * DM))[lane + 64 * j]; }
            const float p = (lane < 32) ? hstats[(size_t)m * 32 + lane] : 0.f;
            const float rstd = rsqrtf(wave_sum(p) * (1.0f / 2048.0f) + 1e-5f);
            f32x4* orow = (f32x4*)(H + (size_t)m * DM);
#pragma unroll
            for (int j = 0; j < 4; ++j) {
                f32x4 a, b; if (MK_RESID == 3) pg8::h8_to_f32(hb[j], a, b); else pg8::bf8_to_f32(hb[j], a, b);
                if (MK_RESID == 2) { f32x4 c, d; pg8::bf8_to_f32(lo[j], c, d); a = a + c; b = b + d; }
                orow[2 * (lane + 64 * j)] = a * rstd * g[j][0]; orow[2 * (lane + 64 * j) + 1] = b * rstd * g[j][1];
            }
        }
    }
}

constexpr int G_RV = 0, G_WC = 1024, G_WCP = 272, G_VT = 36864, G_VTP = 528;
__device__ __forceinline__ void gate_phase(LAS unsigned char* lds, const bf16* U, const bf16* V, bf16* G, const float* vstats, const float* Ws, const float* bs, const float* gnorm, int blk, int nblk) {
    const int tid = opaque_tid(), lane = tid & 63, wid = __builtin_amdgcn_readfirstlane(tid >> 6), l15 = lane & 15, fq = lane >> 4;
    LAS float* RV = (LAS float*)(lds + G_RV);
    for (int unit = blk; unit < 512; unit += nblk) {
        const int chunk = unit >> 3, g = unit & 7, R0 = chunk * 128;
        const int srow = tid >> 2, sq = tid & 3;
        const f32x4* sp = (const f32x4*)(vstats + (size_t)(R0 + srow) * 32 + sq * 8);
        const f32x4 sa = sp[0], sb = sp[1];
        v4u val[8]; f32x4 wsv[8]; v2u uu[8][2]; f32x4 gn[2]; float bb[8];
#pragma unroll
        for (int i = 0; i < 8; ++i) { const int idx = i * NTHREADS + tid, s_ = idx >> 5, dc = (idx & 31) * 8; val[i] = *(const v4u*)(V + (size_t)(R0 + s_) * DM + g * 256 + dc); }
#pragma unroll
        for (int i = 0; i < 8; ++i) { const int idx = i * NTHREADS + tid, t = idx >> 5, s4 = (idx & 31) * 4; wsv[i] = *(const f32x4*)(Ws + (size_t)(g * 128 + t) * 128 + s4); }
#pragma unroll
        for (int nt = 0; nt < 2; ++nt) {
            const int col = g * 256 + 32 * wid + 16 * nt + 4 * fq;
            gn[nt] = *(const f32x4*)(gnorm + col);
#pragma unroll
            for (int mt = 0; mt < 8; ++mt) uu[mt][nt] = *(const v2u*)(U + (size_t)(R0 + 16 * mt + l15) * DM + col);
        }
#pragma unroll
        for (int mt = 0; mt < 8; ++mt) bb[mt] = bs[g * 128 + 16 * mt + l15];
        {
            float s_ = ((sa[0] + sa[1]) + (sa[2] + sa[3])) + ((sb[0] + sb[1]) + (sb[2] + sb[3]));
            s_ += __shfl_xor(s_, 1); s_ += __shfl_xor(s_, 2);
            if (sq == 0) RV[srow] = rsqrtf(s_ * (1.0f / 2048.0f) + 1e-5f);
        }
#pragma unroll
        for (int i = 0; i < 8; ++i) { const int idx = i * NTHREADS + tid, s_ = idx >> 5, dc = (idx & 31) * 8; *(LAS v4u*)(lds + G_VT + s_ * G_VTP + dc * 2) = val[i]; }
        __syncthreads();
#pragma unroll
        for (int i = 0; i < 8; ++i) {
            const int idx = i * NTHREADS + tid, t = idx >> 5, s4 = (idx & 31) * 4;
            f32x4 w = wsv[i];
            const f32x4 r = *(const LAS f32x4*)(RV + s4);
#pragma unroll
            for (int e = 0; e < 4; ++e) w[e] = (s4 + e <= t) ? w[e] * r[e] : 0.f;
            v2u o; o.x = pk2(w[0], w[1]); o.y = pk2(w[2], w[3]);
            *(LAS v2u*)(lds + G_WC + t * G_WCP + s4 * 2) = o;
        }
        __syncthreads();
        f32x4 acc[8][2];
#pragma unroll
        for (int mt = 0; mt < 8; ++mt) { acc[mt][0] = (f32x4){0.f, 0.f, 0.f, 0.f}; acc[mt][1] = (f32x4){0.f, 0.f, 0.f, 0.f}; }
#pragma unroll
        for (int ks = 0; ks < 4; ++ks) {
            bf16x8 vf[2];
#pragma unroll
            for (int nt = 0; nt < 2; ++nt)
#pragma unroll
                for (int j = 0; j < 8; ++j)
                    vf[nt][j] = (short)*(const LAS unsigned short*)(lds + G_VT + (32 * ks + 8 * fq + j) * G_VTP + (32 * wid + 16 * nt + l15) * 2);
#pragma unroll
            for (int mt = 0; mt < 8; ++mt) {
                if (2 * ks < mt + 1) {
                    const bf16x8 wf = *(const LAS bf16x8*)(lds + G_WC + (16 * mt + l15) * G_WCP + (32 * ks + 8 * fq) * 2);
                    acc[mt][0] = mfma16(vf[0], wf, acc[mt][0], 0, 0, 0);
                    acc[mt][1] = mfma16(vf[1], wf, acc[mt][1], 0, 0, 0);
                }
            }
        }
#pragma unroll
        for (int nt = 0; nt < 2; ++nt) {
            const int col = g * 256 + 32 * wid + 16 * nt + 4 * fq;
#pragma unroll
            for (int mt = 0; mt < 8; ++mt) {
                const int t = 16 * mt + l15; const float b = bb[mt];
                const v2u u2 = uu[mt][nt];
                const float u0 = unpk_lo(u2.x), u1 = unpk_hi(u2.x), u2f = unpk_lo(u2.y), u3 = unpk_hi(u2.y);
                const f32x4 a = acc[mt][nt];
                v2u o; o.x = pk2(u0 * (gn[nt][0] * a[0] + b), u1 * (gn[nt][1] * a[1] + b)); o.y = pk2(u2f * (gn[nt][2] * a[2] + b), u3 * (gn[nt][3] * a[3] + b));
                *(v2u*)(G + (size_t)(R0 + t) * DM + col) = o;
            }
        }
        __syncthreads();
    }
}

constexpr int A_KS = 0, A_KSP = 144, A_VT = 36864, A_VTP = 528, A_LUT = 70656;
__device__ __forceinline__ void attn_phase(LAS unsigned char* lds, const bf16* Q, const bf16* KV, bf16* O, const float* sinks, const float* rel_bias, int blk, int nblk) {
    const int tid = opaque_tid(), lane = tid & 63, wid = __builtin_amdgcn_readfirstlane(tid >> 6), l15 = lane & 15, fq = lane >> 4;
    LAS float* LUT = (LAS float*)(lds + A_LUT);
    constexpr float LOG2E = 1.4426950408889634f;
    for (int unit = blk; unit < 256; unit += nblk) {
        const int hk = unit & 3, c = (unit >> 2) & 15, b = unit >> 6;
        const int rowq0 = b * SEQ + c * 128, rowk0 = rowq0 - 128;
        v4u kva[4], vva[4];
#pragma unroll
        for (int i = 0; i < 4; ++i) {
            const int idx = i * NTHREADS + tid, kk = idx >> 3, c8 = idx & 7;
            const bool ok = (c > 0) || (kk >= 128);
            kva[i] = (v4u){0u, 0u, 0u, 0u}; vva[i] = (v4u){0u, 0u, 0u, 0u};
            if (ok) { const bf16* p = KV + (size_t)(rowk0 + kk) * 512 + hk * 64 + c8 * 8; kva[i] = *(const v4u*)p; vva[i] = *(const v4u*)(p + 256); }
        }
#pragma unroll
        for (int i = 0; i < 4; ++i) {
            const int idx = i * NTHREADS + tid, kk = idx >> 3, c8 = idx & 7;
            const v4u kv = kva[i], vv = vva[i];
            *(LAS v4u*)(lds + A_KS + kk * A_KSP + c8 * 16) = kv;
            const int kp = (kk & ~31) + ((kk >> 2) & 3) * 8 + ((kk >> 4) & 1) * 4 + (kk & 3);
            LAS unsigned short* vt = (LAS unsigned short*)(lds + A_VT + (c8 * 8) * A_VTP + kp * 2);
            vt[0 * (A_VTP / 2)] = (unsigned short)(vv.x & 0xffffu); vt[1 * (A_VTP / 2)] = (unsigned short)(vv.x >> 16);
            vt[2 * (A_VTP / 2)] = (unsigned short)(vv.y & 0xffffu); vt[3 * (A_VTP / 2)] = (unsigned short)(vv.y >> 16);
            vt[4 * (A_VTP / 2)] = (unsigned short)(vv.z & 0xffffu); vt[5 * (A_VTP / 2)] = (unsigned short)(vv.z >> 16);
            vt[6 * (A_VTP / 2)] = (unsigned short)(vv.w & 0xffffu); vt[7 * (A_VTP / 2)] = (unsigned short)(vv.w >> 16);
        }
#pragma unroll
        for (int i = 0; i < 3; ++i) {
            const int idx = i * NTHREADS + tid, hh = idx / 192, dist = idx - hh * 192 - 32;
            float val = -1e30f;
            if (dist >= 0 && dist < 128) {
                int bucket = dist;
                if (dist >= 16) { bucket = 16 + (int)(__log2f((float)dist * 0.0625f) * (16.0f / 3.0f)); bucket = bucket > 31 ? 31 : bucket; }
                val = rel_bias[bucket * NH + hk * 8 + hh] * LOG2E;
            }
            LUT[idx] = val;
        }
        __syncthreads();
        const int h = hk * 8 + wid; const float sink = sinks[h] * LOG2E;
        const LAS float* lutb = LUT + wid * 192 + 32 + l15 + 128 - 4 * fq;
        const bf16* qbase = Q + (size_t)(rowq0 + l15) * DM + h * 64 + 8 * fq;
        bf16x8 qall[8][2];
#pragma unroll
        for (int t = 0; t < 8; ++t) { qall[t][0] = *(const bf16x8*)(qbase + (size_t)(16 * t) * DM); qall[t][1] = *(const bf16x8*)(qbase + (size_t)(16 * t) * DM + 32); }
#pragma unroll
        for (int qp = 0; qp < 4; ++qp) {
            const int kt0 = 2 * qp;
            bf16x8 qf[2][2];
#pragma unroll
            for (int t = 0; t < 2; ++t) { qf[t][0] = qall[2 * qp + t][0]; qf[t][1] = qall[2 * qp + t][1]; }
            f32x4 acc[2][10];
            const LAS unsigned char* kb = lds + A_KS + (16 * kt0 + l15) * A_KSP + 16 * fq;
#pragma unroll
            for (int r = 0; r < 10; ++r) {
                const LAS unsigned char* kp = kb + r * 16 * A_KSP;
                const bf16x8 k0 = *(const LAS bf16x8*)kp, k1 = *(const LAS bf16x8*)(kp + 64);
#pragma unroll
                for (int t = 0; t < 2; ++t) {
                    f32x4 z = {0.f, 0.f, 0.f, 0.f};
                    z = mfma16(k0, qf[t][0], z, 0, 0, 0);
                    acc[t][r] = mfma16(k1, qf[t][1], z, 0, 0, 0);
                }
            }
            float inv[2];
#pragma unroll
            for (int t = 0; t < 2; ++t) {
                float mx = -1e30f;
                float lb[10][4];
#pragma unroll
                for (int r = 0; r < 10; ++r)
#pragma unroll
                    for (int j = 0; j < 4; ++j) lb[r][j] = lutb[16 * (t - r) - j];
#pragma unroll
                for (int r = 0; r < 10; ++r) {
                    const float pen = ((c == 0) && (kt0 + r < 8)) ? -1e30f : 0.f;
#pragma unroll
                    for (int j = 0; j < 4; ++j) {
                        const float sc = acc[t][r][j] + (lb[r][j] + pen);
                        acc[t][r][j] = sc; mx = fmaxf(mx, sc);
                    }
                }
                mx = fmaxf(mx, __shfl_xor(mx, 16)); mx = fmaxf(mx, __shfl_xor(mx, 32)); mx = fmaxf(mx, sink);
                float sum = 0.f;
#pragma unroll
                for (int r = 0; r < 10; ++r)
#pragma unroll
                    for (int j = 0; j < 4; ++j) { const float pe = __builtin_amdgcn_exp2f(acc[t][r][j] - mx); acc[t][r][j] = pe; sum += pe; }
                sum += __shfl_xor(sum, 16); sum += __shfl_xor(sum, 32);
                sum += __builtin_amdgcn_exp2f(sink - mx);
                inv[t] = 1.0f / sum;
            }
            f32x4 o[2][4];
#pragma unroll
            for (int t = 0; t < 2; ++t)
#pragma unroll
                for (int dt = 0; dt < 4; ++dt) o[t][dt] = (f32x4){0.f, 0.f, 0.f, 0.f};
            const LAS unsigned char* vb = lds + A_VT + l15 * A_VTP + (32 * qp + 8 * fq) * 2;
#pragma unroll
            for (int cs = 0; cs < 5; ++cs) {
                bf16x8 pf[2];
#pragma unroll
                for (int t = 0; t < 2; ++t) {
                    v4u pw; pw.x = pk2(acc[t][2 * cs][0], acc[t][2 * cs][1]); pw.y = pk2(acc[t][2 * cs][2], acc[t][2 * cs][3]); pw.z = pk2(acc[t][2 * cs + 1][0], acc[t][2 * cs + 1][1]); pw.w = pk2(acc[t][2 * cs + 1][2], acc[t][2 * cs + 1][3]);
                    pf[t] = __builtin_bit_cast(bf16x8, pw);
                }
#pragma unroll
                for (int dt = 0; dt < 4; ++dt) {
                    const bf16x8 vf = *(const LAS bf16x8*)(vb + (16 * dt) * A_VTP + cs * 64);
                    o[0][dt] = mfma16(vf, pf[0], o[0][dt], 0, 0, 0);
                    o[1][dt] = mfma16(vf, pf[1], o[1][dt], 0, 0, 0);
                }
            }
#pragma unroll
            for (int t = 0; t < 2; ++t) {
                bf16* op = O + (size_t)(rowq0 + 16 * (2 * qp + t) + l15) * DM + h * 64 + 4 * fq;
#pragma unroll
                for (int dt = 0; dt < 4; ++dt) { v2u w; w.x = pk2(o[t][dt][0] * inv[t], o[t][dt][1] * inv[t]); w.y = pk2(o[t][dt][2] * inv[t], o[t][dt][3] * inv[t]); *(v2u*)(op + 16 * dt) = w; }
            }
        }
        __syncthreads();
    }
}

struct Args { const float* in[21]; float* out; unsigned char* ws; int ph_lo, ph_hi; };
__global__ void __launch_bounds__(NTHREADS, 2) mk_fwd(Args a_unused) {
    extern __shared__ __attribute__((aligned(16))) unsigned char lds_raw[];
    LAS unsigned char* lds = (LAS unsigned char*)lds_raw;
    const int blk = blockIdx.x, nblk = gridDim.x;
    const KAS Args* ap = (const KAS Args*)__builtin_amdgcn_kernarg_segment_ptr();
    const int ph_hi = ap->ph_hi;
#if MK_COOP
    volatile LAS unsigned* MISC = (volatile LAS unsigned*)(lds + MISC_OFF);
    if (threadIdx.x < 2) MISC[threadIdx.x] = 0u;
    __syncthreads();
    XcdBarrier bar = xcd_barrier_post((unsigned*)ap->ws, MISC);
#endif
    for (int ph = ap->ph_lo; ph < ph_hi; ++ph) {
        const KAS Args* p = ap; asm volatile("" : "+s"(p));
        unsigned char* ws = p->ws;
        float* H = p->out; bf16* HB = (bf16*)(ws + WS_HB);
        float* hstats = (float*)(ws + WS_HSTAT); float* vstats = (float*)(ws + WS_VSTAT);
        bf16* B1 = (bf16*)(ws + WS_B1); bf16* B2 = (bf16*)(ws + WS_B2); bf16* B3 = (bf16*)(ws + WS_B3);
        bf16* ACT = (bf16*)(ws + WS_ACT); bf16* KVB = (bf16*)(ws + WS_KV);
        float* xbuf = (float*)(ws + WS_XB); unsigned* sflags = (unsigned*)(ws + CTL_FLAGS);
        const bool split_ok = MK_SPLIT && (nblk == 256);
        int nrep = 1;
#ifdef MK_PROBE
        { const int sub_ = (ph - 1) % 5; const bool mid = ph > 0 && ph < N_PHASES - 1;
          if ((MK_PROBE & 1) && ph == 0) nrep = 2;
          if ((MK_PROBE & 2) && mid && sub_ == 1) nrep = 2;
          if ((MK_PROBE & 4) && mid && sub_ == 3) nrep = 2;
          if ((MK_PROBE & 8) && mid && sub_ == 0) nrep = 2; }
#endif
        for (int rep = 0; rep < nrep; ++rep) {
        if (ph == 0) prologue_phase(lds, p->in, H, ws, blk, nblk);
        else if (ph == N_PHASES - 1) final_phase(H, HB, (const bf16*)(ws + WS_LO), hstats, p->in[20], blk, nblk);
        else {
            const int L = (ph - 1) / 5, sub = (ph - 1) % 5, i = L - 2;
            if (sub == 0) {
                if (L < 2) {
                    pg8::Gemm g{HB, (const bf16*)(ws + WS_AIN + (size_t)L * 16 * MiB), M, 4096, DM, DM / 64}; pg8::StaticOrder S; S.init(M, 4096, nblk, blk);
                    PG8_LAS float* tab = (PG8_LAS float*)(lds + TAB_OFF); pg8::build_ms_table(tab, hstats, S);
                    pg8::EpiGeluUV E{B1, B2, hstats, vstats, tab};
                    pg8::gemm_phase<pg8::EpiGeluUV, pg8::StaticOrder, true, true>(lds, g, S, E);
                } else {
                    const bool split = split_ok && (i == 0);
                    const int N = (i == 0 && !split) ? 2560 : 2048;
                    pg8::Gemm g{HB, (const bf16*)(ws + (i ? WS_Q1 : WS_Q0)), M, N, DM, DM / 64}; pg8::StaticOrder S; S.init(M, N, nblk, blk);
#if MK_LAZY
                    if (i == 0) { tail_convert(lds, p->in, ws, SET_PH11, split ? 256 : 320, blk, nblk); __syncthreads(); }
#endif
                    PG8_LAS float* tab = split ? (PG8_LAS float*)nullptr : (PG8_LAS float*)(lds + TAB_OFF); if (!split) pg8::build_ms_table(tab, hstats, S);
                    pg8::EpiQKV E{B1, KVB, hstats, p->in[12] + i * DM, p->in[10], 0.125f * 1.4426950408889634f, tab};
                    pg8::Unit su; pg8::SplitOrder S2{S, 0, 4, 64, 1, blk}; bool has_split = false;
                    if (split) {
                        has_split = S2.next(0, su);
                        pg8::Gemm g2{HB, (const bf16*)(ws + WS_Q0), M, 2560, DM, 8};
                        pg8::EpiStore E2{xbuf, sflags + 4 * 128, 4};
                        pg8::gemm_phase<pg8::EpiStore, pg8::SplitOrder, false, true>(lds, g2, S2, E2);
                    }
                    pg8::gemm_phase<pg8::EpiQKV, pg8::StaticOrder, true, true>(lds, g, S, E);
                    if (has_split) pg8::split_fixup(E, xbuf, sflags + 4 * 128, 4, su);
                }
            } else if (sub == 1) {
                if (L < 2) gate_phase(lds, B1, B2, B3, vstats, p->in[5] + (size_t)L * 8 * 128 * 128, p->in[6] + L * 8 * 128, p->in[4] + L * DM, blk, nblk);
                else attn_phase(lds, B1, KVB, B2, p->in[13] + i * NH, p->in[16], blk, nblk);
            } else if (sub == 3) {
                pg8::Gemm g{HB, (const bf16*)(ws + WS_FUP + (size_t)L * 44 * MiB), M, 2 * DFF, DM, DM / 64}; pg8::StaticOrder S; S.init(M, 2 * DFF, nblk, blk);
                if (split_ok) S.limit = 1280;
#if MK_LAZY
                tail_convert(lds, p->in, ws, L == 0 ? SET_PH4 : L == 1 ? SET_PH9 : L == 2 ? SET_PH14 : SET_PH19, split_ok ? 256 : 1408, blk, nblk);
                __syncthreads();
#endif
                PG8_LAS float* tab = split_ok ? (PG8_LAS float*)nullptr : (PG8_LAS float*)(lds + TAB_OFF); if (!split_ok) pg8::build_ms_table(tab, hstats, S);
                pg8::EpiSwiglu E{ACT, hstats, tab};
                pg8::Unit su; pg8::SplitOrder S2{S, 1280, 2, 128, 0, blk}; bool has_split = false;
                if (split_ok) {
                    has_split = S2.next(0, su);
                    pg8::Gemm g2{HB, (const bf16*)(ws + WS_FUP + (size_t)L * 44 * MiB), M, 2 * DFF, DM, 16};
                    pg8::EpiStore E2{xbuf, sflags + L * 128, 2};
                    pg8::gemm_phase<pg8::EpiStore, pg8::SplitOrder, false, true>(lds, g2, S2, E2);
                }
                pg8::gemm_phase<pg8::EpiSwiglu, pg8::StaticOrder, true, true>(lds, g, S, E);
                if (has_split) pg8::split_fixup(E, xbuf, sflags + L * 128, 2, su);
            } else {
                const bf16* A; const bf16* Bt; int K; const float* bias = nullptr;
                if (sub == 2) { K = DM; if (L < 2) { A = B3; Bt = (const bf16*)(ws + WS_AOUT + (size_t)L * 8 * MiB); } else { A = B2; Bt = (const bf16*)(ws + WS_WO + (size_t)i * 8 * MiB); bias = p->in[15] + i * DM; } }
                else { K = DFF; A = ACT; Bt = (const bf16*)(ws + WS_FDN + (size_t)L * 22 * MiB); }
                pg8::Gemm g{A, Bt, M, DM, K, K / 64}; pg8::StaticOrder S; S.init(M, DM, nblk, blk);
                pg8::EpiResid E{H, HB, hstats, bias, (ph == 3) ? p->in[0] : (MK_RESID == 0 ? (const float*)H : (const float*)nullptr), (bf16*)(ws + WS_LO)};
                pg8::gemm_phase<pg8::EpiResid, pg8::StaticOrder, true, true>(lds, g, S, E);
            }
        }
        }
        if (ph + 1 < ph_hi) {
#if MK_COOP
            if (ph_hi > 1000) cg::this_grid().sync();
            xcd_barrier(bar);
#endif
        }
    }
}

extern "C" void kernel_launch(void* const* d_in, const int* in_sizes, int n_in, void* d_out, int out_size, void* d_ws, size_t ws_size, hipStream_t stream) {
    static int grid = 0;
    if (grid == 0) {
        if (n_in != 21 || out_size != M * DM || ws_size < WS_END) { fprintf(stderr, "kernel_launch: unexpected shapes (n_in %d out %d ws %zu)\n", n_in, out_size, ws_size); grid = -1; return; }
        int dev = 0, cus = 0, per_cu = 0;
        hipGetDevice(&dev); hipDeviceGetAttribute(&cus, hipDeviceAttributeMultiprocessorCount, dev);
        hipFuncSetAttribute((const void*)mk_fwd, hipFuncAttributeMaxDynamicSharedMemorySize, LDS_BYTES);
        if (hipOccupancyMaxActiveBlocksPerMultiprocessor(&per_cu, (const void*)mk_fwd, NTHREADS, LDS_BYTES) != hipSuccess || per_cu < 1) per_cu = 1;
        (void)hipGetLastError();
        grid = cus * per_cu;
        if (grid <= 0) grid = 256;
    }
    if (grid < 0) return;
    Args a{};
    for (int i = 0; i < 21; ++i) a.in[i] = (const float*)d_in[i];
    a.out = (float*)d_out; a.ws = (unsigned char*)d_ws;
#if MK_COOP
    if (hipMemsetAsync(d_ws, 0, CTL_ZERO_BYTES, stream) != hipSuccess) { fprintf(stderr, "kernel_launch: memset failed\n"); return; }
    a.ph_lo = 0; a.ph_hi = N_PHASES;
    void* args[] = {&a};
    hipError_t e = hipLaunchCooperativeKernel((const void*)mk_fwd, dim3(grid), dim3(NTHREADS), args, LDS_BYTES, stream);
    if (e != hipSuccess) fprintf(stderr, "cooperative launch failed: %s (grid %d)\n", hipGetErrorString(e), grid);
#else
    for (int ph = 0; ph < N_PHASES; ++ph) {
        a.ph_lo = ph; a.ph_hi = ph + 1;
        hipLaunchKernelGGL(mk_fwd, dim3(grid), dim3(NTHREADS), LDS_BYTES, stream, a);
    }
#endif
}
```

```cpp
#include <hip/hip_runtime.h>
#include <hip/hip_cooperative_groups.h>
#include <cstdio>
#include <cstdint>
namespace cg = cooperative_groups;
#ifndef MK_COOP
#define MK_COOP 1
#endif
#ifndef MK_SPLIT
#define MK_SPLIT 0
#endif
#ifndef MK_LAZY
#define MK_LAZY 1
#endif
#ifndef MK_RESID
#define MK_RESID 1
#endif
__device__ __forceinline__ int opaque_tid() { int t = threadIdx.x; asm volatile("" : "+v"(t)); return t; }
#ifndef MK_F16
#define MK_F16 0
#endif
typedef _Float16 h16x2_t __attribute__((ext_vector_type(2)));
typedef _Float16 h16x8_t __attribute__((ext_vector_type(8)));
typedef short s16x8_t __attribute__((ext_vector_type(8)));
typedef float f32x4_t __attribute__((ext_vector_type(4)));
__device__ __forceinline__ unsigned pkh16(float lo, float hi) { unsigned r; asm volatile("v_cvt_pk_f16_f32 %0, %1, %2" : "=v"(r) : "v"(lo), "v"(hi)); return r; }
__device__ __forceinline__ float unpkh_lo(unsigned w) { return (float)__builtin_bit_cast(h16x2_t, w)[0]; }
__device__ __forceinline__ float unpkh_hi(unsigned w) { return (float)__builtin_bit_cast(h16x2_t, w)[1]; }
#if MK_F16
__device__ __forceinline__ unsigned pk16(float lo, float hi) { unsigned r; asm volatile("v_cvt_pk_f16_f32 %0, %1, %2" : "=v"(r) : "v"(lo), "v"(hi)); return r; }
__device__ __forceinline__ float unpk_lo(unsigned w) { return (float)__builtin_bit_cast(h16x2_t, w)[0]; }
__device__ __forceinline__ float unpk_hi(unsigned w) { return (float)__builtin_bit_cast(h16x2_t, w)[1]; }
__device__ __forceinline__ f32x4_t mfma16(s16x8_t a, s16x8_t b, f32x4_t c, int, int, int) { return __builtin_amdgcn_mfma_f32_16x16x32_f16(__builtin_bit_cast(h16x8_t, a), __builtin_bit_cast(h16x8_t, b), c, 0, 0, 0); }
#else
__device__ __forceinline__ unsigned pk16(float lo, float hi) { unsigned r; asm volatile("v_cvt_pk_bf16_f32 %0, %1, %2" : "=v"(r) : "v"(lo), "v"(hi)); return r; }
__device__ __forceinline__ float unpk_lo(unsigned w) { return __uint_as_float(w << 16); }
__device__ __forceinline__ float unpk_hi(unsigned w) { return __uint_as_float(w & 0xffff0000u); }
__device__ __forceinline__ f32x4_t mfma16(s16x8_t a, s16x8_t b, f32x4_t c, int, int, int) { return __builtin_amdgcn_mfma_f32_16x16x32_bf16(a, b, c, 0, 0, 0); }
#endif
namespace pg8 {
#define PG8_LAS __attribute__((address_space(3)))
typedef unsigned short bf16_t;
typedef short bf16x8 __attribute__((ext_vector_type(8)));
typedef float f32x4 __attribute__((ext_vector_type(4)));
typedef unsigned u32x4 __attribute__((ext_vector_type(4)));
constexpr int BM = 256, BK = 64, HALF = 128, HTB = HALF * BK * 2  , STAGE_BYTES = 8 * HTB, NXCD = 8, WGM = 8;

__host__ __device__ __forceinline__ int lds_byte(int r, int c) { const int st = (r >> 4) * 2 + (c >> 5), rr = r & 15, cc = c & 31, ob = rr * 64 + cc * 2; return st * 1024 + (ob ^ (((ob >> 9) & 1) << 5)); }
__host__ __device__ __forceinline__ void stage_rc(int b, int& R, int& C) { const int st = b / 1024, sb = b % 1024, swz = sb ^ (((sb >> 9) & 1) << 5); R = (st >> 1) * 16 + swz / 64; C = (st & 1) * 32 + (swz % 64) / 2; }
__host__ __device__ __forceinline__ int perm32(int rho) { const int n = rho >> 4, i = rho & 15; return 8 * (i >> 2) + 4 * n + (i & 3); }

struct Unit { int pm, pn, kp, slot; };
struct Gemm { const bf16_t* A; const bf16_t* Bt; int M, N, K, nt; };

struct StaticOrder {
    int nM, nN, nwg, G, c, limit;
    __host__ __device__ void init(int M, int N, int G_, int c_) { nM = M / BM; nN = N / BM; nwg = nM * nN; G = G_; c = c_; limit = nwg; }
    __host__ __device__ void map(int L, Unit& u) const {
        int wgid = L; { const int q = nwg / NXCD, r = nwg % NXCD, xcd = wgid % NXCD, off = wgid / NXCD; wgid = (xcd < r ? xcd * (q + 1) : r * (q + 1) + (xcd - r) * q) + off; }
        const int nig = WGM * nN, gid = wgid / nig, fm = gid * WGM, gsz = (nM - fm) < WGM ? (nM - fm) : WGM;
        u.pm = fm + ((wgid % nig) % gsz); u.pn = (wgid % nig) / gsz; u.kp = 0; u.slot = 0;
    }
    __host__ __device__ bool next(int i, Unit& u) const {
        const long L = (long)i * G + c; if (L >= limit) return false;
        map((int)L, u); u.slot = i; return true;
    }
    __device__ __forceinline__ void a_ready(const Unit&) const {}
    __device__ __forceinline__ void done(const Unit&) const {}
};
struct SplitOrder {
    StaticOrder base; int L0, S, ntiles, kvmode, c;
    __device__ bool next(int i, Unit& u) const {
        if (i > 0) return false;
        const int slot = (c / (8 * S)) * 8 + (c & 7); if (slot >= ntiles) return false;
        if (kvmode) { u.pm = slot >> 1; u.pn = 8 + (slot & 1); } else base.map(L0 + slot, u);
        u.kp = (c >> 3) % S; u.slot = slot; return true;
    }
    __device__ __forceinline__ void a_ready(const Unit&) const {}
    __device__ __forceinline__ void done(const Unit&) const {}
};

__device__ __forceinline__ unsigned cvt_pk_bf16(float lo, float hi) { return pk16(lo, hi); }
typedef float f32x2 __attribute__((ext_vector_type(2)));
__device__ __forceinline__ float fast_sigmoid_mul(float x, float z) {   return x * __builtin_amdgcn_rcpf(1.0f + __builtin_amdgcn_exp2f(z * -1.4426950408889634f)); }
__device__ __forceinline__ float gelu_tanh(float x) { const float y2 = x * (1.5957691216057308f + 0.07135481627f * x * x); return fast_sigmoid_mul(x, y2); }
__device__ __forceinline__ float silu_f(float x) { return fast_sigmoid_mul(x, x); }
__device__ __forceinline__ void row_rstd(const float* stats, int row0, int fq, float (&rs)[2][4]) {
#pragma unroll
    for (int ai = 0; ai < 2; ++ai) {
        f32x4 pa[4], pb[4];
#pragma unroll
        for (int m = 0; m < 4; ++m) { const f32x4* p = (const f32x4*)(stats + (size_t)(row0 + ai * HALF + m * 16) * 32 + fq * 8); pa[m] = p[0]; pb[m] = p[1]; }
#pragma unroll
        for (int m = 0; m < 4; ++m) {
            const f32x4 a = pa[m], b = pb[m];
            float s = ((a[0] + a[1]) + (a[2] + a[3])) + ((b[0] + b[1]) + (b[2] + b[3]));
            s += __shfl_xor(s, 16); s += __shfl_xor(s, 32);
            rs[ai][m] = rsqrtf(s * (1.0f / 2048.0f) + 1e-5f);
        }
    }
}
__device__ __forceinline__ void row_rstd2(const float* stats, int row0, int fq, float (&rs)[2][4], float (&ms)[2][4]) {
#pragma unroll
    for (int ai = 0; ai < 2; ++ai) {
        f32x4 pa[4], pb[4];
#pragma unroll
        for (int m = 0; m < 4; ++m) { const f32x4* p = (const f32x4*)(stats + (size_t)(row0 + ai * HALF + m * 16) * 32 + fq * 8); pa[m] = p[0]; pb[m] = p[1]; }
#pragma unroll
        for (int m = 0; m < 4; ++m) {
            const f32x4 a = pa[m], b = pb[m];
            float s = ((a[0] + a[1]) + (a[2] + a[3])) + ((b[0] + b[1]) + (b[2] + b[3]));
            s += __shfl_xor(s, 16); s += __shfl_xor(s, 32);
            ms[ai][m] = s * (1.0f / 2048.0f) + 1e-5f; rs[ai][m] = rsqrtf(ms[ai][m]);
        }
    }
}
__device__ __forceinline__ void build_ms_table(PG8_LAS float* tab, const float* stats, const StaticOrder& S) {
    const int tid = opaque_tid(), row = tid >> 1, half = tid & 1;
    Unit u0, u; const bool any = S.next(0, u0); if (!any) return;
    f32x4 v[6][4];
#pragma unroll
    for (int i = 0; i < 6; ++i) {
        if (!S.next(i, u)) u = u0;
        const f32x4* p = (const f32x4*)(stats + (size_t)(u.pm * BM + row) * 32 + half * 16);
#pragma unroll
        for (int k = 0; k < 4; ++k) v[i][k] = p[k];
    }
#pragma unroll
    for (int i = 0; i < 6; ++i) {
        float sm = 0.f;
#pragma unroll
        for (int k = 0; k < 4; ++k) sm += (v[i][k][0] + v[i][k][1]) + (v[i][k][2] + v[i][k][3]);
        sm += __shfl_xor(sm, 1);
        if (half == 0) tab[i * BM + row] = sm * (1.0f / 2048.0f) + 1e-5f;
    }
}
__device__ __forceinline__ void tab_rstd(const PG8_LAS float* tab, const Unit& u, int wr, int fr, float (&rs)[2][4], float (&ms)[2][4]) {
#pragma unroll
    for (int ai = 0; ai < 2; ++ai)
#pragma unroll
        for (int m = 0; m < 4; ++m) { ms[ai][m] = tab[u.slot * BM + ai * HALF + wr * 64 + m * 16 + fr]; rs[ai][m] = rsqrtf(ms[ai][m]); }
}
__device__ __forceinline__ u32x4 pack8(const f32x4 v0, const f32x4 v1) { u32x4 w; w.x = cvt_pk_bf16(v0[0], v0[1]); w.y = cvt_pk_bf16(v0[2], v0[3]); w.z = cvt_pk_bf16(v1[0], v1[1]); w.w = cvt_pk_bf16(v1[2], v1[3]); return w; }
__device__ __forceinline__ float sq8(const f32x4 v0, const f32x4 v1) { return ((v0[0] * v0[0] + v0[1] * v0[1]) + (v0[2] * v0[2] + v0[3] * v0[3])) + ((v1[0] * v1[0] + v1[1] * v1[1]) + (v1[2] * v1[2] + v1[3] * v1[3])); }

struct EpiGeluUV {
    static constexpr bool PERM = true, AFTER_DRAIN = false;
    bf16_t* U; bf16_t* V; const float* hstats; float* vstats; const PG8_LAS float* tab;
    __device__ __forceinline__ void operator()(const f32x4 (&acc)[2][2][4][2], const Unit& u, int wr, int wc, int fr, int fq) const {
        const int row0 = u.pm * BM + wr * 64 + fr;
        float rs[2][4], ms_[2][4]; tab_rstd(tab, u, wr, fr, rs, ms_);
        const bool isv = u.pn >= 8; const int ct = isv ? u.pn - 8 : u.pn;
        bf16_t* base = isv ? V : U; const int col0 = ct * BM + wc * 32 + 8 * fq;
#pragma unroll
        for (int ai = 0; ai < 2; ++ai)
#pragma unroll
            for (int m = 0; m < 4; ++m) {
                const int row = row0 + ai * HALF + m * 16; const float r = rs[ai][m]; float ss = 0.f;
#pragma unroll
                for (int bj = 0; bj < 2; ++bj) {
                    f32x4 v0 = acc[ai][bj][m][0] * r, v1 = acc[ai][bj][m][1] * r;
#pragma unroll
                    for (int e = 0; e < 4; ++e) { v0[e] = gelu_tanh(v0[e]); v1[e] = gelu_tanh(v1[e]); }
                    ss += sq8(v0, v1);
                    *(u32x4*)(base + (size_t)row * 2048 + col0 + bj * HALF) = pack8(v0, v1);
                }
                if (isv) { ss += __shfl_xor(ss, 16); ss += __shfl_xor(ss, 32); if (fq == 0) vstats[(size_t)row * 32 + ct * 4 + wc] = ss; }
            }
    }
};
__device__ __forceinline__ void bf8_to_f32(const u32x4 w, f32x4& a, f32x4& b) {
    a[0] = unpk_lo(w.x); a[1] = unpk_hi(w.x); a[2] = unpk_lo(w.y); a[3] = unpk_hi(w.y);
    b[0] = unpk_lo(w.z); b[1] = unpk_hi(w.z); b[2] = unpk_lo(w.w); b[3] = unpk_hi(w.w);
}
__device__ __forceinline__ void h8_to_f32(const u32x4 w, f32x4& a, f32x4& b) {
    a[0] = unpkh_lo(w.x); a[1] = unpkh_hi(w.x); a[2] = unpkh_lo(w.y); a[3] = unpkh_hi(w.y);
    b[0] = unpkh_lo(w.z); b[1] = unpkh_hi(w.z); b[2] = unpkh_lo(w.w); b[3] = unpkh_hi(w.w);
}
struct EpiResid {
    static constexpr bool PERM = true, AFTER_DRAIN = false;
    float* H; bf16_t* HB; float* hstats; const float* bias; const float* Hin;
    bf16_t* LO;
    __device__ __forceinline__ void operator()(const f32x4 (&acc)[2][2][4][2], const Unit& u, int wr, int wc, int fr, int fq) const {
        const int row0 = u.pm * BM + wr * 64 + fr; const int col0 = u.pn * BM + wc * 32 + 8 * fq;
        f32x4 bv[2][2];
#pragma unroll
        for (int bj = 0; bj < 2; ++bj)
#pragma unroll
            for (int n = 0; n < 2; ++n) bv[bj][n] = bias ? *(const f32x4*)(bias + col0 + bj * HALF + 4 * n) : (f32x4){0.f, 0.f, 0.f, 0.f};
        if (Hin) {
            f32x4 hv[3][2][2];
#define RESID_LOAD(buf, g) do { _Pragma("unroll") for (int bj = 0; bj < 2; ++bj) { \
            const float* hp_ = Hin + (size_t)(row0 + ((g) >> 2) * HALF + ((g) & 3) * 16) * 2048 + col0 + bj * HALF; hv[buf][bj][0] = *(const f32x4*)hp_; hv[buf][bj][1] = *(const f32x4*)(hp_ + 4); } } while (0)
            RESID_LOAD(0, 0); RESID_LOAD(1, 1);
#pragma unroll
            for (int g = 0; g < 8; ++g) {
                const int ai = g >> 2, m = g & 3;
                if (g + 2 < 8) RESID_LOAD((g + 2) % 3, g + 2);
                const int row = row0 + ai * HALF + m * 16; float ss = 0.f;
#pragma unroll
                for (int bj = 0; bj < 2; ++bj) {
                    f32x4 h0 = hv[g % 3][bj][0], h1 = hv[g % 3][bj][1];
                    h0 = h0 + (acc[ai][bj][m][0] + bv[bj][0]); h1 = h1 + (acc[ai][bj][m][1] + bv[bj][1]);
                    store_h(row, col0 + bj * HALF, h0, h1);
                    ss += sq8(h0, h1);
                }
                ss += __shfl_xor(ss, 16); ss += __shfl_xor(ss, 32);
                if (fq == 0) hstats[(size_t)row * 32 + u.pn * 4 + wc] = ss;
            }
#undef RESID_LOAD
        } else {
            constexpr int NB = (MK_RESID == 2) ? 2 : 3;
            u32x4 hv[NB][2][2];
#define RESID_LOAD(buf, g) do { _Pragma("unroll") for (int bj = 0; bj < 2; ++bj) { \
            const size_t o_ = (size_t)(row0 + ((g) >> 2) * HALF + ((g) & 3) * 16) * 2048 + col0 + bj * HALF; hv[buf][bj][0] = *(const u32x4*)((MK_RESID == 3 ? LO : HB) + o_); if (MK_RESID == 2) hv[buf][bj][1] = *(const u32x4*)(LO + o_); } } while (0)
            RESID_LOAD(0, 0); if (NB == 3) RESID_LOAD(1, 1);
#pragma unroll
            for (int g = 0; g < 8; ++g) {
                const int ai = g >> 2, m = g & 3;
                if (g + NB - 1 < 8) RESID_LOAD((g + NB - 1) % NB, g + NB - 1);
                const int row = row0 + ai * HALF + m * 16; float ss = 0.f;
#pragma unroll
                for (int bj = 0; bj < 2; ++bj) {
                    f32x4 h0, h1; if (MK_RESID == 3) h8_to_f32(hv[g % NB][bj][0], h0, h1); else bf8_to_f32(hv[g % NB][bj][0], h0, h1);
                    if (MK_RESID == 2) { f32x4 l0, l1; bf8_to_f32(hv[g % NB][bj][1], l0, l1); h0 = h0 + l0; h1 = h1 + l1; }
                    h0 = h0 + (acc[ai][bj][m][0] + bv[bj][0]); h1 = h1 + (acc[ai][bj][m][1] + bv[bj][1]);
                    store_h(row, col0 + bj * HALF, h0, h1);
                    ss += sq8(h0, h1);
                }
                ss += __shfl_xor(ss, 16); ss += __shfl_xor(ss, 32);
                if (fq == 0) hstats[(size_t)row * 32 + u.pn * 4 + wc] = ss;
            }
#undef RESID_LOAD
        }
    }
    __device__ __forceinline__ void store_h(int row, int col, const f32x4 h0, const f32x4 h1) const {
        const size_t o = (size_t)row * 2048 + col;
        const u32x4 hi = pack8(h0, h1);
        *(u32x4*)(HB + o) = hi;
        if (MK_RESID == 0) { *(f32x4*)(H + o) = h0; *(f32x4*)(H + o + 4) = h1; }
        if (MK_RESID == 2) { f32x4 a, b; bf8_to_f32(hi, a, b); *(u32x4*)(LO + o) = pack8(h0 - a, h1 - b); }
        if (MK_RESID == 3) { u32x4 w; w.x = pkh16(h0[0], h0[1]); w.y = pkh16(h0[2], h0[3]); w.z = pkh16(h1[0], h1[1]); w.w = pkh16(h1[2], h1[3]); *(u32x4*)(LO + o) = w; }
    }
};
struct EpiSwiglu {
    static constexpr bool PERM = true, AFTER_DRAIN = false;
    bf16_t* ACT; const float* hstats; const PG8_LAS float* tab;
    __device__ __forceinline__ void operator()(const f32x4 (&acc)[2][2][4][2], const Unit& u, int wr, int wc, int fr, int fq) const { run(acc, u, wr, wc, fr, fq, 3, 3); }
    __device__ __forceinline__ void run(const f32x4 (&acc)[2][2][4][2], const Unit& u, int wr, int wc, int fr, int fq, int aimask, int  ) const {
        const int row0 = u.pm * BM + wr * 64 + fr; const int col0 = u.pn * HALF + wc * 32 + 8 * fq;
        float rs[2][4], ms[2][4]; if (tab) tab_rstd(tab, u, wr, fr, rs, ms); else row_rstd2(hstats, row0, fq, rs, ms);
#pragma unroll
        for (int ai = 0; ai < 2; ++ai) {
            if (!((aimask >> ai) & 1)) continue;
#pragma unroll
            for (int m = 0; m < 4; ++m) {
                const int row = row0 + ai * HALF + m * 16; const float rn = rs[ai][m] * -1.4426950408889634f, mq = ms[ai][m];
                f32x4 g0 = acc[ai][0][m][0], g1 = acc[ai][0][m][1]; const f32x4 u0 = acc[ai][1][m][0], u1 = acc[ai][1][m][1];
#pragma unroll
                for (int e = 0; e < 4; ++e) {
                    const float e0 = __builtin_amdgcn_exp2f(g0[e] * rn), e1 = __builtin_amdgcn_exp2f(g1[e] * rn);
                    g0[e] = (g0[e] * u0[e]) * __builtin_amdgcn_rcpf(__builtin_fmaf(e0, mq, mq)); g1[e] = (g1[e] * u1[e]) * __builtin_amdgcn_rcpf(__builtin_fmaf(e1, mq, mq));
                }
                *(u32x4*)(ACT + (size_t)row * 5632 + col0) = pack8(g0, g1);
            }
        }
    }
};
struct EpiQKV {
    static constexpr bool PERM = true, AFTER_DRAIN = false;
    bf16_t* Q; bf16_t* KV; const float* hstats; const float* bq; const float* bkv; float qscale; const PG8_LAS float* tab;
    __device__ __forceinline__ void operator()(const f32x4 (&acc)[2][2][4][2], const Unit& u, int wr, int wc, int fr, int fq) const { run(acc, u, wr, wc, fr, fq, 3, 3); }
    __device__ __forceinline__ void run(const f32x4 (&acc)[2][2][4][2], const Unit& u, int wr, int wc, int fr, int fq, int aimask, int bjmask) const {
        const int row0 = u.pm * BM + wr * 64 + fr;
        float rs[2][4], ms_[2][4]; if (tab) tab_rstd(tab, u, wr, fr, rs, ms_); else row_rstd(hstats, row0, fq, rs);
        const bool isq = u.pn < 8; const int ct = isq ? u.pn : u.pn - 8; const int ldc = isq ? 2048 : 512;
        bf16_t* base = isq ? Q : KV; const float* bias = isq ? bq : bkv; const float sc = isq ? qscale : 1.0f;
        const int col0 = ct * BM + wc * 32 + 8 * fq;
        f32x4 bv[2][2];
#pragma unroll
        for (int bj = 0; bj < 2; ++bj)
#pragma unroll
            for (int n = 0; n < 2; ++n) bv[bj][n] = *(const f32x4*)(bias + col0 + bj * HALF + 4 * n);
#pragma unroll
        for (int ai = 0; ai < 2; ++ai) {
            if (!((aimask >> ai) & 1)) continue;
#pragma unroll
            for (int m = 0; m < 4; ++m) {
                const int row = row0 + ai * HALF + m * 16; const float r = rs[ai][m];
#pragma unroll
                for (int bj = 0; bj < 2; ++bj) {
                    if (!((bjmask >> bj) & 1)) continue;
                    const f32x4 v0 = (acc[ai][bj][m][0] * r + bv[bj][0]) * sc, v1 = (acc[ai][bj][m][1] * r + bv[bj][1]) * sc;
                    *(u32x4*)(base + (size_t)row * ldc + col0 + bj * HALF) = pack8(v0, v1);
                }
            }
        }
    }
};

struct EpiStore {
    static constexpr bool PERM = true, AFTER_DRAIN = true;
    float* xbuf; unsigned* flags; int S;
    __device__ __forceinline__ void fused(f32x4 (&acc)[2][2][4][2], const Unit& u, int wr, int wc, int fr, int fq, PG8_LAS unsigned char* lds, int wid, int lane) const {
        typedef __attribute__((address_space(1))) unsigned gu32;
        const int tid = wid * 64 + lane;
        const f32x4* dst = (const f32x4*)xbuf + ((size_t)(u.slot * S + u.kp) * 32) * 512 + tid;
#pragma unroll
        for (int ai = 0; ai < 2; ++ai)
#pragma unroll
            for (int bj = 0; bj < 2; ++bj)
#pragma unroll
                for (int m = 0; m < 4; ++m)
#pragma unroll
                    for (int n = 0; n < 2; ++n) {
                        const f32x4 v = acc[ai][bj][m][n]; const f32x4* d = dst + (size_t)(((ai * 2 + bj) * 4 + m) * 2 + n) * 512;
                        asm volatile("global_store_dwordx4 %0, %1, off sc1" :: "v"(d), "v"(v) : "memory");
                    }
        asm volatile("s_waitcnt vmcnt(0)" ::: "memory");
        __syncthreads();
        if (tid == 0) __hip_atomic_fetch_add((gu32*)(flags + u.slot), 1u, __ATOMIC_RELAXED, __HIP_MEMORY_SCOPE_AGENT);
    }
};
template <class Inner> __device__ __forceinline__ void split_fixup(const Inner& inner, const float* xbuf, unsigned* flags, int S, const Unit& u) {
    typedef __attribute__((address_space(1))) unsigned gu32;
    const int tid = opaque_tid(), wid = tid >> 6, lane = tid & 63, wr = wid >> 2, wc = wid & 3, fr = lane & 15, fq = lane >> 4;
    if (tid == 0) {
        unsigned sp = 0;
        while (__hip_atomic_load((gu32*)(flags + u.slot), __ATOMIC_RELAXED, __HIP_MEMORY_SCOPE_AGENT) < (unsigned)S) { __builtin_amdgcn_s_sleep(2); if (++sp > (1u << 22)) break; }
        __builtin_amdgcn_fence(__ATOMIC_ACQUIRE, "agent");
        asm volatile("s_waitcnt vmcnt(0)" ::: "memory");
    }
    __syncthreads();
    const int aimask = (S == 2) ? (1 << u.kp) : (1 << (u.kp >> 1)), bjmask = (S == 2) ? 3 : (1 << (u.kp & 1));
    f32x4 acc[2][2][4][2];
#pragma unroll
    for (int ai = 0; ai < 2; ++ai)
#pragma unroll
        for (int bj = 0; bj < 2; ++bj)
#pragma unroll
            for (int m = 0; m < 4; ++m)
#pragma unroll
                for (int n = 0; n < 2; ++n) acc[ai][bj][m][n] = (f32x4){0.f, 0.f, 0.f, 0.f};
    for (int h = 0; h < S; ++h) {
        const f32x4* src = (const f32x4*)xbuf + ((size_t)(u.slot * S + h) * 32) * 512 + tid;
#pragma unroll
        for (int ai = 0; ai < 2; ++ai) {
            if (!((aimask >> ai) & 1)) continue;
#pragma unroll
            for (int bj = 0; bj < 2; ++bj) {
                if (!((bjmask >> bj) & 1)) continue;
                f32x4 t[4][2];
#pragma unroll
                for (int m = 0; m < 4; ++m)
#pragma unroll
                    for (int n = 0; n < 2; ++n) t[m][n] = src[(size_t)(((ai * 2 + bj) * 4 + m) * 2 + n) * 512];
#pragma unroll
                for (int m = 0; m < 4; ++m)
#pragma unroll
                    for (int n = 0; n < 2; ++n) acc[ai][bj][m][n] = acc[ai][bj][m][n] + t[m][n];
            }
        }
    }
    inner.run(acc, u, wr, wc, fr, fq, aimask, bjmask);
}

template <class Epi, class Sched, bool ALIGN_EPI = false, bool SP2 = false>
__device__ __forceinline__ void gemm_phase(PG8_LAS unsigned char* lds, const Gemm g, const Sched& S, const Epi& E) {
    const int tid = opaque_tid(), wid = __builtin_amdgcn_readfirstlane(tid >> 6), lane = tid & 63, wr = wid >> 2, wc = wid & 3, fr = lane & 15, fq = lane >> 4;
    const int K = g.K, nt = g.nt;
    unsigned voffA[2], voffB[2];
#pragma unroll
    for (int i = 0; i < 2; ++i) { int R, C; stage_rc(tid * 16 + i * 8192, R, C); const int Rb = Epi::PERM ? ((R & ~31) + perm32(R & 31)) : R;
        voffA[i] = (unsigned)(R * K + C) * 2u; voffB[i] = (unsigned)(Rb * K + C) * 2u; }
    const size_t kstep = (size_t)(BK * 2);
    const size_t hstep = (size_t)HALF * K * 2;
    const size_t tstep = 2 * hstep;
    const unsigned ldsw = (unsigned)wid * 1024u;
    const int aoff = lds_byte(wr * 64 + fr, fq * 8), boff = lds_byte(wc * 32 + fr, fq * 8);
#define PG8_SA(b, h) (((b) * 2 + (h)) * HTB)
#define PG8_SB(b, h) ((4 + (b) * 2 + (h)) * HTB)
#define PG8_STAGE(bufoff, gbase, voff) do { _Pragma("unroll") for (int _i = 0; _i < 2; ++_i) \
        __builtin_amdgcn_global_load_lds((const unsigned*)((const char*)(gbase) + (voff)[_i]), (PG8_LAS unsigned*)(lds + (bufoff) + ldsw + _i * 8192), 16, 0, 0); } while (0)
#define PG8_LDA(dst, b, h) do { _Pragma("unroll") for (int m = 0; m < 4; ++m) _Pragma("unroll") for (int k = 0; k < 2; ++k) dst[m][k] = *(const PG8_LAS bf16x8*)(lds + PG8_SA(b, h) + aoff + m * 2048 + k * 1024); } while (0)
#define PG8_LDB(dst, b, h) do { _Pragma("unroll") for (int n = 0; n < 2; ++n) _Pragma("unroll") for (int k = 0; k < 2; ++k) dst[n][k] = *(const PG8_LAS bf16x8*)(lds + PG8_SB(b, h) + boff + n * 2048 + k * 1024); } while (0)
#define PG8_MMA(ai, bj, At, Bt) do { __builtin_amdgcn_s_setprio(1); _Pragma("unroll") for (int m = 0; m < 4; ++m) _Pragma("unroll") for (int n = 0; n < 2; ++n) _Pragma("unroll") for (int k = 0; k < 2; ++k) \
        acc[ai][bj][m][n] = mfma16(Bt[n][k], At[m][k], acc[ai][bj][m][n], 0, 0, 0); __builtin_amdgcn_s_setprio(0); } while (0)
#define PG8_WAIT_V(n) asm volatile("s_waitcnt vmcnt(" #n ")" ::: "memory")
#define PG8_WAIT_L(n) asm volatile("s_waitcnt lgkmcnt(" #n ")" ::: "memory")
#define PG8_BAR __builtin_amdgcn_s_barrier()
#define PG8_SCHED __builtin_amdgcn_sched_barrier(0)
    Unit cur, nxt; int ui = 0;
    if (!S.next(0, cur)) return;
    f32x4 acc[2][2][4][2];
#pragma unroll
    for (int a = 0; a < 2; ++a)
#pragma unroll
        for (int b = 0; b < 2; ++b)
#pragma unroll
            for (int m = 0; m < 4; ++m)
#pragma unroll
                for (int n = 0; n < 2; ++n) acc[a][b][m][n] = (f32x4){0.f, 0.f, 0.f, 0.f};
    bf16x8 At[4][2], B0[2][2], B1[2][2];
    const size_t kpstep = (size_t)nt * kstep;
    const char* cA = (const char*)g.A + (size_t)cur.pm * tstep + (size_t)cur.kp * kpstep; const char* cB = (const char*)g.Bt + (size_t)cur.pn * tstep + (size_t)cur.kp * kpstep;
    S.a_ready(cur);
    if constexpr (SP2) {
        PG8_STAGE(PG8_SB(0, 0), cB, voffB); PG8_STAGE(PG8_SB(0, 1), cB + hstep, voffB); PG8_STAGE(PG8_SA(0, 0), cA, voffA); PG8_STAGE(PG8_SA(0, 1), cA + hstep, voffA);
        if (wr == 1) PG8_BAR;
        PG8_WAIT_V(2); PG8_BAR;
        PG8_STAGE(PG8_SB(1, 0), cB + kstep, voffB); PG8_STAGE(PG8_SA(1, 0), cA + kstep, voffA); PG8_STAGE(PG8_SB(1, 1), cB + hstep + kstep, voffB);
        PG8_WAIT_V(6); PG8_BAR;
    } else {
        PG8_STAGE(PG8_SB(0, 0), cB, voffB); PG8_STAGE(PG8_SA(0, 0), cA, voffA); PG8_STAGE(PG8_SB(0, 1), cB + hstep, voffB); PG8_STAGE(PG8_SA(0, 1), cA + hstep, voffA);
        if (wr == 1) PG8_BAR;
        PG8_WAIT_V(4); PG8_BAR;
        PG8_STAGE(PG8_SB(1, 0), cB + kstep, voffB); PG8_STAGE(PG8_SA(1, 0), cA + kstep, voffA); PG8_STAGE(PG8_SB(1, 1), cB + hstep + kstep, voffB);
        PG8_WAIT_V(6); PG8_BAR;
    }
    for (;;) {
        const bool has_next = S.next(ui + 1, nxt);
        const char* nA = has_next ? (const char*)g.A + (size_t)nxt.pm * tstep + (size_t)nxt.kp * kpstep : cA; const char* nB = has_next ? (const char*)g.Bt + (size_t)nxt.pn * tstep + (size_t)nxt.kp * kpstep : cB;
        for (int t = 0; t < nt; t += 2) {
            const bool last = (t == nt - 2);
            const char* a1 = cA + (size_t)(t + 1) * kstep;
            const char* a2 = last ? nA : cA + (size_t)(t + 2) * kstep; const char* b2 = last ? nB : cB + (size_t)(t + 2) * kstep;
            const char* a3 = a2 + kstep; const char* b3 = b2 + kstep;
            if (last && has_next) S.a_ready(nxt);
            if constexpr (SP2) {
            PG8_LDB(B0, 0, 0); PG8_LDB(B1, 0, 1); PG8_SCHED; PG8_LDA(At, 0, 0); PG8_STAGE(PG8_SA(1, 1), a1 + hstep, voffA);
            PG8_WAIT_V(8); PG8_WAIT_L(0); PG8_BAR; PG8_MMA(0, 0, At, B0); PG8_MMA(0, 1, At, B1); PG8_BAR; PG8_SCHED;
            PG8_LDA(At, 0, 1); PG8_STAGE(PG8_SB(0, 0), b2, voffB); PG8_STAGE(PG8_SB(0, 1), b2 + hstep, voffB); PG8_STAGE(PG8_SA(0, 0), a2, voffA);
            PG8_WAIT_V(8); PG8_WAIT_L(0); PG8_BAR; PG8_MMA(1, 0, At, B0); PG8_MMA(1, 1, At, B1); PG8_BAR; PG8_SCHED;
            PG8_LDB(B0, 1, 0); PG8_LDB(B1, 1, 1); PG8_SCHED; PG8_LDA(At, 1, 0); PG8_STAGE(PG8_SA(0, 1), a2 + hstep, voffA);
            PG8_WAIT_V(8); PG8_WAIT_L(0); PG8_BAR; PG8_MMA(0, 0, At, B0); PG8_MMA(0, 1, At, B1); PG8_BAR; PG8_SCHED;
            PG8_LDA(At, 1, 1); PG8_STAGE(PG8_SB(1, 0), b3, voffB); PG8_STAGE(PG8_SB(1, 1), b3 + hstep, voffB); PG8_STAGE(PG8_SA(1, 0), a3, voffA);
            PG8_WAIT_V(8); PG8_WAIT_L(0); PG8_BAR; PG8_MMA(1, 0, At, B0); PG8_MMA(1, 1, At, B1); PG8_BAR; PG8_SCHED;
            } else {
            PG8_LDB(B0, 0, 0); PG8_SCHED; PG8_LDA(At, 0, 0); PG8_STAGE(PG8_SA(1, 1), a1 + hstep, voffA);
            PG8_WAIT_L(8); PG8_BAR; PG8_WAIT_L(0); PG8_MMA(0, 0, At, B0); PG8_BAR; PG8_SCHED;
            PG8_LDB(B1, 0, 1); PG8_STAGE(PG8_SB(0, 0), b2, voffB);
            PG8_BAR; PG8_WAIT_L(0); PG8_MMA(0, 1, At, B1); PG8_BAR;
            PG8_LDA(At, 0, 1); PG8_STAGE(PG8_SA(0, 0), a2, voffA);
            PG8_BAR; PG8_WAIT_L(0); PG8_MMA(1, 0, At, B0); PG8_BAR; PG8_SCHED;
            PG8_STAGE(PG8_SB(0, 1), b2 + hstep, voffB);
            PG8_WAIT_V(6); PG8_BAR; PG8_MMA(1, 1, At, B1); PG8_BAR;
            PG8_LDB(B0, 1, 0); PG8_SCHED; PG8_LDA(At, 1, 0); PG8_STAGE(PG8_SA(0, 1), a2 + hstep, voffA);
            PG8_WAIT_L(8); PG8_BAR; PG8_WAIT_L(0); PG8_MMA(0, 0, At, B0); PG8_BAR; PG8_SCHED;
            PG8_LDB(B1, 1, 1); PG8_STAGE(PG8_SB(1, 0), b3, voffB);
            PG8_BAR; PG8_WAIT_L(0); PG8_MMA(0, 1, At, B1); PG8_BAR;
            PG8_LDA(At, 1, 1); PG8_STAGE(PG8_SA(1, 0), a3, voffA);
            PG8_BAR; PG8_WAIT_L(0); PG8_MMA(1, 0, At, B0); PG8_BAR; PG8_SCHED;
            PG8_STAGE(PG8_SB(1, 1), b3 + hstep, voffB);
            PG8_WAIT_V(6); PG8_BAR; PG8_MMA(1, 1, At, B1); PG8_BAR;
            }
        }
        if constexpr (ALIGN_EPI) { if (wr == 0) PG8_BAR; }
        if constexpr (!Epi::AFTER_DRAIN) { E(acc, cur, wr, wc, fr, fq); S.done(cur); }
        if (!has_next) break;
#pragma unroll
        for (int a = 0; a < 2; ++a)
#pragma unroll
            for (int b = 0; b < 2; ++b)
#pragma unroll
                for (int m = 0; m < 4; ++m)
#pragma unroll
                    for (int n = 0; n < 2; ++n) acc[a][b][m][n] = (f32x4){0.f, 0.f, 0.f, 0.f};
        cur = nxt; cA = nA; cB = nB; ++ui;
        if constexpr (ALIGN_EPI) { if (wr == 1) PG8_BAR; }
    }
    PG8_WAIT_V(0);
    if constexpr (!ALIGN_EPI) { if (wr == 0) PG8_BAR; }
    PG8_BAR;
    if constexpr (Epi::AFTER_DRAIN) { E.fused(acc, cur, wr, wc, fr, fq, lds, wid, lane); S.done(cur); }
#undef PG8_SA
#undef PG8_SB
#undef PG8_STAGE
#undef PG8_LDA
#undef PG8_LDB
#undef PG8_MMA
#undef PG8_WAIT_V
#undef PG8_WAIT_L
#undef PG8_BAR
#undef PG8_SCHED
}
}

constexpr int M = 8192, DM = 2048, SEQ = 2048, DFF = 5632, NH = 32, NKV = 4, HD = 64;
constexpr int NWAVES = 8, NTHREADS = 512;
constexpr size_t MiB = 1u << 20;
constexpr size_t WS_HSTAT = 1 * MiB, WS_VSTAT = 2 * MiB;
constexpr size_t WS_AIN = 4 * MiB;
constexpr size_t WS_AOUT = 36 * MiB;
constexpr size_t WS_FUP = 52 * MiB;
constexpr size_t WS_FDN = 228 * MiB;
constexpr size_t WS_Q0 = 316 * MiB;
constexpr size_t WS_Q1 = 326 * MiB;
constexpr size_t WS_WO = 334 * MiB;
constexpr size_t WS_HB = 350 * MiB;
constexpr size_t WS_B1 = 382 * MiB;
constexpr size_t WS_B2 = 414 * MiB;
constexpr size_t WS_B3 = 446 * MiB;
constexpr size_t WS_ACT = 478 * MiB;
constexpr size_t WS_KV = 566 * MiB;
constexpr size_t WS_LO = 638 * MiB;
constexpr size_t WS_XB = 574 * MiB;
constexpr size_t WS_END = 670 * MiB;
constexpr size_t CTL_FLAGS = 32768;
constexpr int LDS_BYTES = 147456;
constexpr int N_PHASES = 22;
constexpr int TAB_OFF = 131072;
constexpr int MISC_OFF = 140 * 1024;
constexpr size_t CTL_ZERO_BYTES = 65536;

#define LAS __attribute__((address_space(3)))
#define KAS __attribute__((address_space(4)))
typedef const float* cfp;
typedef const KAS cfp* kin_t;
typedef unsigned short bf16;
typedef unsigned v4u __attribute__((ext_vector_type(4)));
typedef unsigned v2u __attribute__((ext_vector_type(2)));
typedef float f32x4 __attribute__((ext_vector_type(4)));
typedef short bf16x8 __attribute__((ext_vector_type(8)));
#define LDS_WAIT() asm volatile("s_waitcnt lgkmcnt(0)" ::: "memory")
__device__ __forceinline__ unsigned pk2(float lo, float hi) { return pg8::cvt_pk_bf16(lo, hi); }
__device__ __forceinline__ float bf2f(unsigned short b) { return __uint_as_float((unsigned)b << 16); }
__device__ __forceinline__ float wave_sum(float v) {
#pragma unroll
    for (int o = 1; o < 64; o <<= 1) v += __shfl_xor(v, o);
    return v;
}

#define XB_TMO      128
#define XB_XCNT(j)  (256  + 64 * (j))
#define XB_XSUB(j)  (1280 + 64 * (j))
#define XB_XGEN(j)  (2304 + 64 * (j))
#define XB_TOP      3328
#define XB_TOPGEN   3392
#define XCD_BAR_WORDS 3456
#define XB_SPIN_CAP (1u << 18)

__device__ __forceinline__ unsigned xb_ld(unsigned* p)              { return __hip_atomic_load(p, __ATOMIC_RELAXED, __HIP_MEMORY_SCOPE_AGENT); }
__device__ __forceinline__ unsigned xb_add(unsigned* p, unsigned v) { return __hip_atomic_fetch_add(p, v, __ATOMIC_RELAXED, __HIP_MEMORY_SCOPE_AGENT); }
__device__ __forceinline__ unsigned xb_xcc_id() { return (unsigned)__builtin_amdgcn_s_getreg((3 << 11) | 20) & 0xFu; }
#define XB_SPIN(cond, bar) do { unsigned _sp = 0; while (cond) { __builtin_amdgcn_s_sleep(1); \
    if ((++_sp & 255u) == 0u) { if (xb_ld(&(bar)[XB_TMO])) break; if (_sp > XB_SPIN_CAP) { atomicAdd(&(bar)[XB_TMO], 1u); break; } } } } while (0)

struct XcdBarrier {
    unsigned* bar; unsigned x;
    volatile LAS unsigned* st;
};

__device__ __forceinline__ XcdBarrier xcd_barrier_post(unsigned* bar, volatile LAS unsigned* st) {
    XcdBarrier b; b.bar = bar; b.x = xb_xcc_id(); b.st = st;
    if (threadIdx.x == 0) (void)xb_add(&bar[XB_XCNT(b.x)], 1u);
    return b;
}
__device__ __forceinline__ void xcd_barrier_complete(unsigned* bar, unsigned x, unsigned& nloc, unsigned& nx) {
    const unsigned G = gridDim.x * gridDim.y * gridDim.z;
    unsigned sum, cnt, mine, sp = 0u;
    for (;;) {
        sum = 0u; cnt = 0u; mine = 0u;
#pragma unroll
        for (unsigned j = 0; j < 16; ++j) { const unsigned c = xb_ld(&bar[XB_XCNT(j)]); sum += c; cnt += (c > 0u) ? 1u : 0u; mine = (j == x) ? c : mine; }
        if (sum == G) break;
        __builtin_amdgcn_s_sleep(1);
        if ((++sp & 255u) == 0u) { if (xb_ld(&bar[XB_TMO])) break; if (sp > XB_SPIN_CAP) { atomicAdd(&bar[XB_TMO], 1u); break; } }
    }
    nloc = mine > 0u ? mine : 1u; nx = cnt > 0u ? cnt : 1u;
}

__device__ __forceinline__ void xcd_barrier(const XcdBarrier& b) {
    asm volatile("s_waitcnt vmcnt(0)" ::: "memory");
    __syncthreads();
    if (threadIdx.x == 0) {
        unsigned* bar = b.bar;
        __builtin_amdgcn_s_waitcnt(0);
        unsigned nloc = b.st[0], nx = b.st[1];
        if (nloc == 0u) { xcd_barrier_complete(bar, b.x, nloc, nx); b.st[0] = nloc; b.st[1] = nx; }
        const unsigned old = xb_add(&bar[XB_XSUB(b.x)], 1u);
        const unsigned gen = old / nloc;
        if (old + 1u == (gen + 1u) * nloc) {
            __builtin_amdgcn_fence(__ATOMIC_RELEASE, "agent");
            asm volatile("s_waitcnt vmcnt(0)" ::: "memory");
            const unsigned og = xb_add(&bar[XB_TOP], 1u);
            const unsigned tg = og / nx;
            if (og + 1u == (tg + 1u) * nx) xb_add(&bar[XB_TOPGEN], 1u);
            else XB_SPIN(xb_ld(&bar[XB_TOPGEN]) == tg, bar);
            __builtin_amdgcn_fence(__ATOMIC_ACQUIRE, "agent");
            xb_add(&bar[XB_XGEN(b.x)], 1u);
            asm volatile("s_waitcnt vmcnt(0)" ::: "memory");
        } else {
            XB_SPIN(xb_ld(&bar[XB_XGEN(b.x)]) == gen, bar);
            __builtin_amdgcn_fence(__ATOMIC_ACQUIRE, "agent");
            asm volatile("s_waitcnt vmcnt(0)" ::: "memory");
        }
    }
    __syncthreads();
}

__device__ __forceinline__ void tr_item(const float* W, int K, int N, bf16* WT, int k0, int n0, int drow0, const float* gain, LAS float* scr, int lane) {
    const int lr = lane >> 4, lc = 4 * (lane & 15);
    f32x4 wv[16];
#pragma unroll
    for (int i = 0; i < 16; ++i) wv[i] = *(const f32x4*)(W + (size_t)(k0 + 4 * i + lr) * N + n0 + lc);
#pragma unroll
    for (int i = 0; i < 16; ++i) { LAS float* d = scr + (4 * i + lr) * 65 + lc; d[0] = wv[i][0]; d[1] = wv[i][1]; d[2] = wv[i][2]; d[3] = wv[i][3]; }
    LDS_WAIT();
    const int c = lane & 7;
    f32x4 g0 = {1.f, 1.f, 1.f, 1.f}, g1 = {1.f, 1.f, 1.f, 1.f};
    if (gain) { g0 = *(const f32x4*)(gain + k0 + 8 * c); g1 = *(const f32x4*)(gain + k0 + 8 * c + 4); }
#pragma unroll
    for (int j = 0; j < 8; ++j) {
        const int n = (lane >> 3) + 8 * j; const LAS float* s = scr + (8 * c) * 65 + n;
        v4u o; o.x = pk2(s[0 * 65] * g0[0], s[1 * 65] * g0[1]); o.y = pk2(s[2 * 65] * g0[2], s[3 * 65] * g0[3]);
        o.z = pk2(s[4 * 65] * g1[0], s[5 * 65] * g1[1]); o.w = pk2(s[6 * 65] * g1[2], s[7 * 65] * g1[3]);
        *(v4u*)(WT + (size_t)(drow0 + n) * K + k0 + 8 * c) = o;
    }
    LDS_WAIT();
}
__device__ __forceinline__ void tr_mat(const float* W, int K, int N, bf16* WT, int item, const float* gain, int mode  , LAS float* scr, int lane) {
    const int nblk = N >> 6; const int kb = item / nblk, nb = item - kb * nblk; const int n0 = nb * 64;
    int drow0 = n0;
    if (mode) drow0 = (n0 >> 7) * 256 + (n0 & 127) + (mode == 2 ? 128 : 0);
    tr_item(W, K, N, WT, kb * 64, n0, drow0, gain, scr, lane);
}

__device__ __forceinline__ int mat_items(int id) { return id < 2 ? 32 * 64 : id < 4 ? 32 * 32 : id < 16 ? 32 * 88 : id == 16 ? 32 * 8 : 32 * 32; }
__device__ __forceinline__ void convert_item(int id, int r, kin_t in, unsigned char* ws, LAS float* scr, int lane) {
    const float* mixn = in[1]; const float* ffnn = in[2];
    if (id < 2) tr_mat(in[3] + (size_t)id * DM * 4096, DM, 4096, (bf16*)(ws + WS_AIN + (size_t)id * 16 * MiB), r, mixn + id * DM, 0, scr, lane);
    else if (id < 4) tr_mat(in[7] + (size_t)(id - 2) * DM * DM, DM, DM, (bf16*)(ws + WS_AOUT + (size_t)(id - 2) * 8 * MiB), r, nullptr, 0, scr, lane);
    else if (id < 8) tr_mat(in[17] + (size_t)(id - 4) * DM * DFF, DM, DFF, (bf16*)(ws + WS_FUP + (size_t)(id - 4) * 44 * MiB), r, ffnn + (id - 4) * DM, 1, scr, lane);
    else if (id < 12) tr_mat(in[18] + (size_t)(id - 8) * DM * DFF, DM, DFF, (bf16*)(ws + WS_FUP + (size_t)(id - 8) * 44 * MiB), r, ffnn + (id - 8) * DM, 2, scr, lane);
    else if (id < 16) tr_mat(in[19] + (size_t)(id - 12) * DFF * DM, DFF, DM, (bf16*)(ws + WS_FDN + (size_t)(id - 12) * 22 * MiB), r, nullptr, 0, scr, lane);
    else if (id == 16) tr_mat(in[9], DM, 512, (bf16*)(ws + WS_Q0) + (size_t)2048 * DM, r, in[8], 0, scr, lane);
    else if (id < 19) tr_mat(in[11] + (size_t)(id - 17) * DM * DM, DM, DM, (bf16*)(ws + (id == 18 ? WS_Q1 : WS_Q0)), r, mixn + (2 + id - 17) * DM, 0, scr, lane);
    else tr_mat(in[14] + (size_t)(id - 19) * DM * DM, DM, DM, (bf16*)(ws + WS_WO + (size_t)(id - 19) * 8 * MiB), r, nullptr, 0, scr, lane);
}
__device__ __forceinline__ void convert_set(LAS unsigned char* lds, kin_t in, unsigned char* ws, unsigned long long set, int widx, int nworkers) {
    const int tid = opaque_tid(), lane = tid & 63, wave = __builtin_amdgcn_readfirstlane(tid >> 6);
    LAS float* scr = (LAS float*)(lds + wave * 16640);
    int base = 0;
    for (; (set & 31ull) != 31ull; set >>= 5) {
        const int id = (int)(set & 31ull), n = mat_items(id);
        int start = (widx - base) % nworkers; if (start < 0) start += nworkers;
        for (int r = start; r < n; r += nworkers) convert_item(id, r, in, ws, scr, lane);
        base += n;
    }
}
#define MSET1(a) ((unsigned long long)(a) | (31ull << 5))
#define MSET3(a, b, c) ((unsigned long long)(a) | ((unsigned long long)(b) << 5) | ((unsigned long long)(c) << 10) | (31ull << 15))
#define MSET4(a, b, c, d) ((unsigned long long)(a) | ((unsigned long long)(b) << 5) | ((unsigned long long)(c) << 10) | ((unsigned long long)(d) << 15) | (31ull << 20))
#define MSET7(a, b, c, d, e, f, g) ((unsigned long long)(a) | ((unsigned long long)(b) << 5) | ((unsigned long long)(c) << 10) | ((unsigned long long)(d) << 15) | ((unsigned long long)(e) << 20) | ((unsigned long long)(f) << 25) | ((unsigned long long)(g) << 30) | (31ull << 35))
#if MK_LAZY
#define MSET5(a, b, c, d, e) ((unsigned long long)(a) | ((unsigned long long)(b) << 5) | ((unsigned long long)(c) << 10) | ((unsigned long long)(d) << 15) | ((unsigned long long)(e) << 20) | (31ull << 25))
constexpr unsigned long long SET_PRO = MSET4(0, 2, 4, 8);
constexpr unsigned long long SET_PH4 = MSET5(12, 1, 3, 9, 5), SET_PH9 = MSET4(13, 17, 16, 19), SET_PH11 = MSET3(6, 10, 7), SET_PH14 = MSET4(14, 18, 20, 11), SET_PH19 = MSET1(15);
#endif
__device__ __forceinline__ void tail_convert(LAS unsigned char* lds, kin_t in, unsigned char* ws, unsigned long long set, int nunits, int blk, int nblk) {
    const int nfull = nunits % nblk;
    if (blk < nfull) return;
    const int wave = __builtin_amdgcn_readfirstlane(threadIdx.x >> 6);
    convert_set(lds, in, ws, set, (blk - nfull) * NWAVES + wave, (nblk - nfull) * NWAVES);
}

__device__ __forceinline__ void prologue_phase(LAS unsigned char* lds, kin_t in, float* H, unsigned char* ws, int blk, int nblk) {
    const int tid = opaque_tid(), lane = tid & 63, wave = __builtin_amdgcn_readfirstlane(tid >> 6);
    const int gw = blk * NWAVES + wave, NGW = nblk * NWAVES;
#if MK_LAZY
    convert_set(lds, in, ws, SET_PRO, gw, NGW);
#else
    for (int id = 0; id < 21; ++id) convert_set(lds, in, ws, MSET1(id), gw, NGW);
#endif
    const float* x = in[0]; bf16* HB = (bf16*)(ws + WS_HB); float* hstats = (float*)(ws + WS_HSTAT);
    for (int m = gw; m < M; m += NGW) {
        const f32x4* xr = (const f32x4*)(x + (size_t)m * DM) + lane;
        v2u* hb = (v2u*)(HB + (size_t)m * DM) + lane;
        f32x4 v[8]; float s = 0.f;
#pragma unroll
        for (int j = 0; j < 8; ++j) { v[j] = xr[64 * j]; s += (v[j][0] * v[j][0] + v[j][1] * v[j][1]) + (v[j][2] * v[j][2] + v[j][3] * v[j][3]); }
        const float tot = wave_sum(s);
#pragma unroll
        for (int j = 0; j < 8; ++j) { v2u o; o.x = pk2(v[j][0], v[j][1]); o.y = pk2(v[j][2], v[j][3]); hb[64 * j] = o;
            if (MK_RESID == 3) { v2u l; l.x = pkh16(v[j][0], v[j][1]); l.y = pkh16(v[j][2], v[j][3]); ((v2u*)((bf16*)(ws + WS_LO) + (size_t)m * DM))[lane + 64 * j] = l; }
            if (MK_RESID == 2) { v2u l; l.x = pk2(v[j][0] - unpk_lo(o.x), v[j][1] - unpk_hi(o.x)); l.y = pk2(v[j][2] - unpk_lo(o.y), v[j][3] - unpk_hi(o.y)); ((v2u*)((bf16*)(ws + WS_LO) + (size_t)m * DM))[lane + 64 * j] = l; } }
        if (lane < 32) hstats[(size_t)m * 32 + lane] = (lane == 0) ? tot : 0.f;
    }
}

__device__ __forceinline__ void final_phase(float* H, const bf16* HB, const bf16* LO, const float* hstats, const float* fn, int blk, int nblk) {
    const int tid = opaque_tid(), lane = tid & 63, wave = tid >> 6;
    const int gw = blk * NWAVES + wave, NGW = nblk * NWAVES;
    if (MK_RESID == 0) {
        f32x4 g[8];
#pragma unroll
        for (int j = 0; j < 8; ++j) g[j] = ((const f32x4*)fn)[lane + 64 * j];
        for (int m = gw; m < M; m += NGW) {
            const float p = (lane < 32) ? hstats[(size_t)m * 32 + lane] : 0.f;
            const float rstd = rsqrtf(wave_sum(p) * (1.0f / 2048.0f) + 1e-5f);
            f32x4* hr = (f32x4*)(H + (size_t)m * DM) + lane;
#pragma unroll
            for (int j = 0; j < 8; ++j) { f32x4 v = hr[64 * j]; v = v * rstd * g[j]; hr[64 * j] = v; }
        }
    } else {
        f32x4 g[4][2];
#pragma unroll
        for (int j = 0; j < 4; ++j) { g[j][0] = ((const f32x4*)fn)[2 * (lane + 64 * j)]; g[j][1] = ((const f32x4*)fn)[2 * (lane + 64 * j) + 1]; }
        for (int m = gw; m < M; m += NGW) {
            v4u hb[4], lo[4];
#pragma unroll
            for (int j = 0; j < 4; ++j) { hb[j] = ((const v4u*)((MK_RESID == 3 ? LO : HB) + (size_t)m * DM))[lane + 64 * j]; if (MK_RESID == 2) lo[j] = ((const v4u*)(LO + (size_t)m * DM))[lane + 64 * j]; }
            const float p = (lane < 32) ? hstats[(size_t)m * 32 + lane] : 0.f;
            const float rstd = rsqrtf(wave_sum(p) * (1.0f / 2048.0f) + 1e-5f);
            f32x4* orow = (f32x4*)(H + (size_t)m * DM);
#pragma unroll
            for (int j = 0; j < 4; ++j) {
                f32x4 a, b; if (MK_RESID == 3) pg8::h8_to_f32(hb[j], a, b); else pg8::bf8_to_f32(hb[j], a, b);
                if (MK_RESID == 2) { f32x4 c, d; pg8::bf8_to_f32(lo[j], c, d); a = a + c; b = b + d; }
                orow[2 * (lane + 64 * j)] = a * rstd * g[j][0]; orow[2 * (lane + 64 * j) + 1] = b * rstd * g[j][1];
            }
        }
    }
}

constexpr int G_RV = 0, G_WC = 1024, G_WCP = 272, G_VT = 36864, G_VTP = 528;
__device__ __forceinline__ void gate_phase(LAS unsigned char* lds, const bf16* U, const bf16* V, bf16* G, const float* vstats, const float* Ws, const float* bs, const float* gnorm, int blk, int nblk) {
    const int tid = opaque_tid(), lane = tid & 63, wid = __builtin_amdgcn_readfirstlane(tid >> 6), l15 = lane & 15, fq = lane >> 4;
    LAS float* RV = (LAS float*)(lds + G_RV);
    for (int unit = blk; unit < 512; unit += nblk) {
        const int chunk = unit >> 3, g = unit & 7, R0 = chunk * 128;
        const int srow = tid >> 2, sq = tid & 3;
        const f32x4* sp = (const f32x4*)(vstats + (size_t)(R0 + srow) * 32 + sq * 8);
        const f32x4 sa = sp[0], sb = sp[1];
        v4u val[8]; f32x4 wsv[8]; v2u uu[8][2]; f32x4 gn[2]; float bb[8];
#pragma unroll
        for (int i = 0; i < 8; ++i) { const int idx = i * NTHREADS + tid, s_ = idx >> 5, dc = (idx & 31) * 8; val[i] = *(const v4u*)(V + (size_t)(R0 + s_) * DM + g * 256 + dc); }
#pragma unroll
        for (int i = 0; i < 8; ++i) { const int idx = i * NTHREADS + tid, t = idx >> 5, s4 = (idx & 31) * 4; wsv[i] = *(const f32x4*)(Ws + (size_t)(g * 128 + t) * 128 + s4); }
#pragma unroll
        for (int nt = 0; nt < 2; ++nt) {
            const int col = g * 256 + 32 * wid + 16 * nt + 4 * fq;
            gn[nt] = *(const f32x4*)(gnorm + col);
#pragma unroll
            for (int mt = 0; mt < 8; ++mt) uu[mt][nt] = *(const v2u*)(U + (size_t)(R0 + 16 * mt + l15) * DM + col);
        }
#pragma unroll
        for (int mt = 0; mt < 8; ++mt) bb[mt] = bs[g * 128 + 16 * mt + l15];
        {
            float s_ = ((sa[0] + sa[1]) + (sa[2] + sa[3])) + ((sb[0] + sb[1]) + (sb[2] + sb[3]));
            s_ += __shfl_xor(s_, 1); s_ += __shfl_xor(s_, 2);
            if (sq == 0) RV[srow] = rsqrtf(s_ * (1.0f / 2048.0f) + 1e-5f);
        }
#pragma unroll
        for (int i = 0; i < 8; ++i) { const int idx = i * NTHREADS + tid, s_ = idx >> 5, dc = (idx & 31) * 8; *(LAS v4u*)(lds + G_VT + s_ * G_VTP + dc * 2) = val[i]; }
        __syncthreads();
#pragma unroll
        for (int i = 0; i < 8; ++i) {
            const int idx = i * NTHREADS + tid, t = idx >> 5, s4 = (idx & 31) * 4;
            f32x4 w = wsv[i];
            const f32x4 r = *(const LAS f32x4*)(RV + s4);
#pragma unroll
            for (int e = 0; e < 4; ++e) w[e] = (s4 + e <= t) ? w[e] * r[e] : 0.f;
            v2u o; o.x = pk2(w[0], w[1]); o.y = pk2(w[2], w[3]);
            *(LAS v2u*)(lds + G_WC + t * G_WCP + s4 * 2) = o;
        }
        __syncthreads();
        f32x4 acc[8][2];
#pragma unroll
        for (int mt = 0; mt < 8; ++mt) { acc[mt][0] = (f32x4){0.f, 0.f, 0.f, 0.f}; acc[mt][1] = (f32x4){0.f, 0.f, 0.f, 0.f}; }
#pragma unroll
        for (int ks = 0; ks < 4; ++ks) {
            bf16x8 vf[2];
#pragma unroll
            for (int nt = 0; nt < 2; ++nt)
#pragma unroll
                for (int j = 0; j < 8; ++j)
                    vf[nt][j] = (short)*(const LAS unsigned short*)(lds + G_VT + (32 * ks + 8 * fq + j) * G_VTP + (32 * wid + 16 * nt + l15) * 2);
#pragma unroll
            for (int mt = 0; mt < 8; ++mt) {
                if (2 * ks < mt + 1) {
                    const bf16x8 wf = *(const LAS bf16x8*)(lds + G_WC + (16 * mt + l15) * G_WCP + (32 * ks + 8 * fq) * 2);
                    acc[mt][0] = mfma16(vf[0], wf, acc[mt][0], 0, 0, 0);
                    acc[mt][1] = mfma16(vf[1], wf, acc[mt][1], 0, 0, 0);
                }
            }
        }
#pragma unroll
        for (int nt = 0; nt < 2; ++nt) {
            const int col = g * 256 + 32 * wid + 16 * nt + 4 * fq;
#pragma unroll
            for (int mt = 0; mt < 8; ++mt) {
                const int t = 16 * mt + l15; const float b = bb[mt];
                const v2u u2 = uu[mt][nt];
                const float u0 = unpk_lo(u2.x), u1 = unpk_hi(u2.x), u2f = unpk_lo(u2.y), u3 = unpk_hi(u2.y);
                const f32x4 a = acc[mt][nt];
                v2u o; o.x = pk2(u0 * (gn[nt][0] * a[0] + b), u1 * (gn[nt][1] * a[1] + b)); o.y = pk2(u2f * (gn[nt][2] * a[2] + b), u3 * (gn[nt][3] * a[3] + b));
                *(v2u*)(G + (size_t)(R0 + t) * DM + col) = o;
            }
        }
        __syncthreads();
    }
}

constexpr int A_KS = 0, A_KSP = 144, A_VT = 36864, A_VTP = 528, A_LUT = 70656;
__device__ __forceinline__ void attn_phase(LAS unsigned char* lds, const bf16* Q, const bf16* KV, bf16* O, const float* sinks, const float* rel_bias, int blk, int nblk) {
    const int tid = opaque_tid(), lane = tid & 63, wid = __builtin_amdgcn_readfirstlane(tid >> 6), l15 = lane & 15, fq = lane >> 4;
    LAS float* LUT = (LAS float*)(lds + A_LUT);
    constexpr float LOG2E = 1.4426950408889634f;
    for (int unit = blk; unit < 256; unit += nblk) {
        const int hk = unit & 3, c = (unit >> 2) & 15, b = unit >> 6;
        const int rowq0 = b * SEQ + c * 128, rowk0 = rowq0 - 128;
        const int h = hk * 8 + wid; const float sink = sinks[h] * LOG2E;
        const bf16* qbase = Q + (size_t)(rowq0 + l15) * DM + h * 64 + 8 * fq;
        bf16x8 qall[8][2];
#pragma unroll
        for (int t = 0; t < 8; ++t) { qall[t][0] = *(const bf16x8*)(qbase + (size_t)(16 * t) * DM); qall[t][1] = *(const bf16x8*)(qbase + (size_t)(16 * t) * DM + 32); }
        v4u kva[4], vva[4];
#pragma unroll
        for (int i = 0; i < 4; ++i) {
            const int idx = i * NTHREADS + tid, kk = idx >> 3, c8 = idx & 7;
            const bool ok = (c > 0) || (kk >= 128);
            kva[i] = (v4u){0u, 0u, 0u, 0u}; vva[i] = (v4u){0u, 0u, 0u, 0u};
            if (ok) { const bf16* p = KV + (size_t)(rowk0 + kk) * 512 + hk * 64 + c8 * 8; kva[i] = *(const v4u*)p; vva[i] = *(const v4u*)(p + 256); }
        }
#pragma unroll
        for (int i = 0; i < 4; ++i) {
            const int idx = i * NTHREADS + tid, kk = idx >> 3, c8 = idx & 7;
            const v4u kv = kva[i], vv = vva[i];
            *(LAS v4u*)(lds + A_KS + kk * A_KSP + c8 * 16) = kv;
            const int kp = (kk & ~31) + ((kk >> 2) & 3) * 8 + ((kk >> 4) & 1) * 4 + (kk & 3);
            LAS unsigned short* vt = (LAS unsigned short*)(lds + A_VT + (c8 * 8) * A_VTP + kp * 2);
            vt[0 * (A_VTP / 2)] = (unsigned short)(vv.x & 0xffffu); vt[1 * (A_VTP / 2)] = (unsigned short)(vv.x >> 16);
            vt[2 * (A_VTP / 2)] = (unsigned short)(vv.y & 0xffffu); vt[3 * (A_VTP / 2)] = (unsigned short)(vv.y >> 16);
            vt[4 * (A_VTP / 2)] = (unsigned short)(vv.z & 0xffffu); vt[5 * (A_VTP / 2)] = (unsigned short)(vv.z >> 16);
            vt[6 * (A_VTP / 2)] = (unsigned short)(vv.w & 0xffffu); vt[7 * (A_VTP / 2)] = (unsigned short)(vv.w >> 16);
        }
#pragma unroll
        for (int i = 0; i < 3; ++i) {
            const int idx = i * NTHREADS + tid, hh = idx / 192, dist = idx - hh * 192 - 32;
            float val = -1e30f;
            if (dist >= 0 && dist < 128) {
                int bucket = dist;
                if (dist >= 16) { bucket = 16 + (int)(__log2f((float)dist * 0.0625f) * (16.0f / 3.0f)); bucket = bucket > 31 ? 31 : bucket; }
                val = rel_bias[bucket * NH + hk * 8 + hh] * LOG2E;
            }
            LUT[idx] = val;
        }
        __syncthreads();
        const LAS float* lutb = LUT + wid * 192 + 32 + l15 + 128 - 4 * fq;
#pragma unroll
        for (int qp = 0; qp < 4; ++qp) {
            const int kt0 = 2 * qp;
            bf16x8 qf[2][2];
#pragma unroll
            for (int t = 0; t < 2; ++t) { qf[t][0] = qall[2 * qp + t][0]; qf[t][1] = qall[2 * qp + t][1]; }
            f32x4 acc[2][10];
            const LAS unsigned char* kb = lds + A_KS + (16 * kt0 + l15) * A_KSP + 16 * fq;
#pragma unroll
            for (int r = 0; r < 10; ++r) {
                const LAS unsigned char* kp = kb + r * 16 * A_KSP;
                const bf16x8 k0 = *(const LAS bf16x8*)kp, k1 = *(const LAS bf16x8*)(kp + 64);
#pragma unroll
                for (int t = 0; t < 2; ++t) {
                    f32x4 z = {0.f, 0.f, 0.f, 0.f};
                    z = mfma16(k0, qf[t][0], z, 0, 0, 0);
                    acc[t][r] = mfma16(k1, qf[t][1], z, 0, 0, 0);
                }
            }
            float inv[2];
#pragma unroll
            for (int t = 0; t < 2; ++t) {
                float mx = -1e30f;
                float lb[10][4];
#pragma unroll
                for (int r = 0; r < 10; ++r)
#pragma unroll
                    for (int j = 0; j < 4; ++j) lb[r][j] = lutb[16 * (t - r) - j];
#pragma unroll
                for (int r = 0; r < 10; ++r) {
                    const float pen = ((c == 0) && (kt0 + r < 8)) ? -1e30f : 0.f;
#pragma unroll
                    for (int j = 0; j < 4; ++j) {
                        const float sc = acc[t][r][j] + (lb[r][j] + pen);
                        acc[t][r][j] = sc; mx = fmaxf(mx, sc);
                    }
                }
                mx = fmaxf(mx, __shfl_xor(mx, 16)); mx = fmaxf(mx, __shfl_xor(mx, 32)); mx = fmaxf(mx, sink);
                float sum = 0.f;
#pragma unroll
                for (int r = 0; r < 10; ++r)
#pragma unroll
                    for (int j = 0; j < 4; ++j) { const float pe = __builtin_amdgcn_exp2f(acc[t][r][j] - mx); acc[t][r][j] = pe; sum += pe; }
                sum += __shfl_xor(sum, 16); sum += __shfl_xor(sum, 32);
                sum += __builtin_amdgcn_exp2f(sink - mx);
                inv[t] = 1.0f / sum;
            }
            f32x4 o[2][4];
#pragma unroll
            for (int t = 0; t < 2; ++t)
#pragma unroll
                for (int dt = 0; dt < 4; ++dt) o[t][dt] = (f32x4){0.f, 0.f, 0.f, 0.f};
            const LAS unsigned char* vb = lds + A_VT + l15 * A_VTP + (32 * qp + 8 * fq) * 2;
#pragma unroll
            for (int cs = 0; cs < 5; ++cs) {
                bf16x8 pf[2];
#pragma unroll
                for (int t = 0; t < 2; ++t) {
                    v4u pw; pw.x = pk2(acc[t][2 * cs][0], acc[t][2 * cs][1]); pw.y = pk2(acc[t][2 * cs][2], acc[t][2 * cs][3]); pw.z = pk2(acc[t][2 * cs + 1][0], acc[t][2 * cs + 1][1]); pw.w = pk2(acc[t][2 * cs + 1][2], acc[t][2 * cs + 1][3]);
                    pf[t] = __builtin_bit_cast(bf16x8, pw);
                }
#pragma unroll
                for (int dt = 0; dt < 4; ++dt) {
                    const bf16x8 vf = *(const LAS bf16x8*)(vb + (16 * dt) * A_VTP + cs * 64);
                    o[0][dt] = mfma16(vf, pf[0], o[0][dt], 0, 0, 0);
                    o[1][dt] = mfma16(vf, pf[1], o[1][dt], 0, 0, 0);
                }
            }
#pragma unroll
            for (int t = 0; t < 2; ++t) {
                bf16* op = O + (size_t)(rowq0 + 16 * (2 * qp + t) + l15) * DM + h * 64 + 4 * fq;
#pragma unroll
                for (int dt = 0; dt < 4; ++dt) { v2u w; w.x = pk2(o[t][dt][0] * inv[t], o[t][dt][1] * inv[t]); w.y = pk2(o[t][dt][2] * inv[t], o[t][dt][3] * inv[t]); *(v2u*)(op + 16 * dt) = w; }
            }
        }
        __syncthreads();
    }
}

struct Args { const float* in[21]; float* out; unsigned char* ws; int ph_lo, ph_hi; };
__global__ void __launch_bounds__(NTHREADS, 2) mk_fwd(Args a_unused) {
    extern __shared__ __attribute__((aligned(16))) unsigned char lds_raw[];
    LAS unsigned char* lds = (LAS unsigned char*)lds_raw;
    const int blk = blockIdx.x, nblk = gridDim.x;
    const KAS Args* ap = (const KAS Args*)__builtin_amdgcn_kernarg_segment_ptr();
    const int ph_hi = ap->ph_hi;
#if MK_COOP
    volatile LAS unsigned* MISC = (volatile LAS unsigned*)(lds + MISC_OFF);
    if (threadIdx.x < 2) MISC[threadIdx.x] = 0u;
    __syncthreads();
    XcdBarrier bar = xcd_barrier_post((unsigned*)ap->ws, MISC);
#endif
    for (int ph = ap->ph_lo; ph < ph_hi; ++ph) {
        const KAS Args* p = ap; asm volatile("" : "+s"(p));
        unsigned char* ws = p->ws;
        float* H = p->out; bf16* HB = (bf16*)(ws + WS_HB);
        float* hstats = (float*)(ws + WS_HSTAT); float* vstats = (float*)(ws + WS_VSTAT);
        bf16* B1 = (bf16*)(ws + WS_B1); bf16* B2 = (bf16*)(ws + WS_B2); bf16* B3 = (bf16*)(ws + WS_B3);
        bf16* ACT = (bf16*)(ws + WS_ACT); bf16* KVB = (bf16*)(ws + WS_KV);
        float* xbuf = (float*)(ws + WS_XB); unsigned* sflags = (unsigned*)(ws + CTL_FLAGS);
        const bool split_ok = MK_SPLIT && (nblk == 256);
        int nrep = 1;
#ifdef MK_PROBE
        { const int sub_ = (ph - 1) % 5; const bool mid = ph > 0 && ph < N_PHASES - 1;
          if ((MK_PROBE & 1) && ph == 0) nrep = 2;
          if ((MK_PROBE & 2) && mid && sub_ == 1) nrep = 2;
          if ((MK_PROBE & 4) && mid && sub_ == 3) nrep = 2;
          if ((MK_PROBE & 8) && mid && sub_ == 0) nrep = 2; }
#endif
        for (int rep = 0; rep < nrep; ++rep) {
        if (ph == 0) prologue_phase(lds, p->in, H, ws, blk, nblk);
        else if (ph == N_PHASES - 1) final_phase(H, HB, (const bf16*)(ws + WS_LO), hstats, p->in[20], blk, nblk);
        else {
            const int L = (ph - 1) / 5, sub = (ph - 1) % 5, i = L - 2;
            if (sub == 0) {
                if (L < 2) {
                    pg8::Gemm g{HB, (const bf16*)(ws + WS_AIN + (size_t)L * 16 * MiB), M, 4096, DM, DM / 64}; pg8::StaticOrder S; S.init(M, 4096, nblk, blk);
                    PG8_LAS float* tab = (PG8_LAS float*)(lds + TAB_OFF); pg8::build_ms_table(tab, hstats, S);
                    pg8::EpiGeluUV E{B1, B2, hstats, vstats, tab};
                    pg8::gemm_phase<pg8::EpiGeluUV, pg8::StaticOrder, true, true>(lds, g, S, E);
                } else {
                    const bool split = split_ok && (i == 0);
                    const int N = (i == 0 && !split) ? 2560 : 2048;
                    pg8::Gemm g{HB, (const bf16*)(ws + (i ? WS_Q1 : WS_Q0)), M, N, DM, DM / 64}; pg8::StaticOrder S; S.init(M, N, nblk, blk);
#if MK_LAZY
                    if (i == 0) { tail_convert(lds, p->in, ws, SET_PH11, split ? 256 : 320, blk, nblk); __syncthreads(); }
#endif
                    PG8_LAS float* tab = split ? (PG8_LAS float*)nullptr : (PG8_LAS float*)(lds + TAB_OFF); if (!split) pg8::build_ms_table(tab, hstats, S);
                    pg8::EpiQKV E{B1, KVB, hstats, p->in[12] + i * DM, p->in[10], 0.125f * 1.4426950408889634f, tab};
                    pg8::Unit su; pg8::SplitOrder S2{S, 0, 4, 64, 1, blk}; bool has_split = false;
                    if (split) {
                        has_split = S2.next(0, su);
                        pg8::Gemm g2{HB, (const bf16*)(ws + WS_Q0), M, 2560, DM, 8};
                        pg8::EpiStore E2{xbuf, sflags + 4 * 128, 4};
                        pg8::gemm_phase<pg8::EpiStore, pg8::SplitOrder, false, true>(lds, g2, S2, E2);
                    }
                    pg8::gemm_phase<pg8::EpiQKV, pg8::StaticOrder, true, true>(lds, g, S, E);
                    if (has_split) pg8::split_fixup(E, xbuf, sflags + 4 * 128, 4, su);
                }
            } else if (sub == 1) {
                if (L < 2) gate_phase(lds, B1, B2, B3, vstats, p->in[5] + (size_t)L * 8 * 128 * 128, p->in[6] + L * 8 * 128, p->in[4] + L * DM, blk, nblk);
                else attn_phase(lds, B1, KVB, B2, p->in[13] + i * NH, p->in[16], blk, nblk);
            } else if (sub == 3) {
                pg8::Gemm g{HB, (const bf16*)(ws + WS_FUP + (size_t)L * 44 * MiB), M, 2 * DFF, DM, DM / 64}; pg8::StaticOrder S; S.init(M, 2 * DFF, nblk, blk);
                if (split_ok) S.limit = 1280;
#if MK_LAZY
                tail_convert(lds, p->in, ws, L == 0 ? SET_PH4 : L == 1 ? SET_PH9 : L == 2 ? SET_PH14 : SET_PH19, split_ok ? 256 : 1408, blk, nblk);
                __syncthreads();
#endif
                PG8_LAS float* tab = split_ok ? (PG8_LAS float*)nullptr : (PG8_LAS float*)(lds + TAB_OFF); if (!split_ok) pg8::build_ms_table(tab, hstats, S);
                pg8::EpiSwiglu E{ACT, hstats, tab};
                pg8::Unit su; pg8::SplitOrder S2{S, 1280, 2, 128, 0, blk}; bool has_split = false;
                if (split_ok) {
                    has_split = S2.next(0, su);
                    pg8::Gemm g2{HB, (const bf16*)(ws + WS_FUP + (size_t)L * 44 * MiB), M, 2 * DFF, DM, 16};
                    pg8::EpiStore E2{xbuf, sflags + L * 128, 2};
                    pg8::gemm_phase<pg8::EpiStore, pg8::SplitOrder, false, true>(lds, g2, S2, E2);
                }
                pg8::gemm_phase<pg8::EpiSwiglu, pg8::StaticOrder, true, true>(lds, g, S, E);
                if (has_split) pg8::split_fixup(E, xbuf, sflags + L * 128, 2, su);
            } else {
                const bf16* A; const bf16* Bt; int K; const float* bias = nullptr;
                if (sub == 2) { K = DM; if (L < 2) { A = B3; Bt = (const bf16*)(ws + WS_AOUT + (size_t)L * 8 * MiB); } else { A = B2; Bt = (const bf16*)(ws + WS_WO + (size_t)i * 8 * MiB); bias = p->in[15] + i * DM; } }
                else { K = DFF; A = ACT; Bt = (const bf16*)(ws + WS_FDN + (size_t)L * 22 * MiB); }
                pg8::Gemm g{A, Bt, M, DM, K, K / 64}; pg8::StaticOrder S; S.init(M, DM, nblk, blk);
                pg8::EpiResid E{H, HB, hstats, bias, (ph == 3) ? p->in[0] : (MK_RESID == 0 ? (const float*)H : (const float*)nullptr), (bf16*)(ws + WS_LO)};
                pg8::gemm_phase<pg8::EpiResid, pg8::StaticOrder, true, true>(lds, g, S, E);
            }
        }
        }
        if (ph + 1 < ph_hi) {
#if MK_COOP
            if (ph_hi > 1000) cg::this_grid().sync();
            xcd_barrier(bar);
#endif
        }
    }
}

extern "C" void kernel_launch(void* const* d_in, const int* in_sizes, int n_in, void* d_out, int out_size, void* d_ws, size_t ws_size, hipStream_t stream) {
    static int grid = 0;
    if (grid == 0) {
        if (n_in != 21 || out_size != M * DM || ws_size < WS_END) { fprintf(stderr, "kernel_launch: unexpected shapes (n_in %d out %d ws %zu)\n", n_in, out_size, ws_size); grid = -1; return; }
        int dev = 0, cus = 0, per_cu = 0;
        hipGetDevice(&dev); hipDeviceGetAttribute(&cus, hipDeviceAttributeMultiprocessorCount, dev);
        hipFuncSetAttribute((const void*)mk_fwd, hipFuncAttributeMaxDynamicSharedMemorySize, LDS_BYTES);
        if (hipOccupancyMaxActiveBlocksPerMultiprocessor(&per_cu, (const void*)mk_fwd, NTHREADS, LDS_BYTES) != hipSuccess || per_cu < 1) per_cu = 1;
        (void)hipGetLastError();
        grid = cus * per_cu;
        if (grid <= 0) grid = 256;
    }
    if (grid < 0) return;
    Args a{};
    for (int i = 0; i < 21; ++i) a.in[i] = (const float*)d_in[i];
    a.out = (float*)d_out; a.ws = (unsigned char*)d_ws;
#if MK_COOP
    if (hipMemsetAsync(d_ws, 0, CTL_ZERO_BYTES, stream) != hipSuccess) { fprintf(stderr, "kernel_launch: memset failed\n"); return; }
    a.ph_lo = 0; a.ph_hi = N_PHASES;
    void* args[] = {&a};
    hipError_t e = hipLaunchCooperativeKernel((const void*)mk_fwd, dim3(grid), dim3(NTHREADS), args, LDS_BYTES, stream);
    if (e != hipSuccess) fprintf(stderr, "cooperative launch failed: %s (grid %d)\n", hipGetErrorString(e), grid);
#else
    for (int ph = 0; ph < N_PHASES; ++ph) {
        a.ph_lo = ph; a.ph_hi = ph + 1;
        hipLaunchKernelGGL(mk_fwd, dim3(grid), dim3(NTHREADS), LDS_BYTES, stream, a);
    }
#endif
}
```

```cpp
#include <hip/hip_runtime.h>
#include <hip/hip_cooperative_groups.h>
#include <cstdio>
#include <cstdint>
namespace cg = cooperative_groups;
#ifndef MK_COOP
#define MK_COOP 1
#endif
#ifndef MK_SPLIT
#define MK_SPLIT 0
#endif
#ifndef MK_LAZY
#define MK_LAZY 1
#endif
#ifndef MK_RESID
#define MK_RESID 1
#endif
__device__ __forceinline__ int opaque_tid() { int t = threadIdx.x; asm volatile("" : "+v"(t)); return t; }
#ifndef MK_F16
#define MK_F16 0
#endif
typedef _Float16 h16x2_t __attribute__((ext_vector_type(2)));
typedef _Float16 h16x8_t __attribute__((ext_vector_type(8)));
typedef short s16x8_t __attribute__((ext_vector_type(8)));
typedef float f32x4_t __attribute__((ext_vector_type(4)));
__device__ __forceinline__ unsigned pkh16(float lo, float hi) { unsigned r; asm volatile("v_cvt_pk_f16_f32 %0, %1, %2" : "=v"(r) : "v"(lo), "v"(hi)); return r; }
__device__ __forceinline__ float unpkh_lo(unsigned w) { return (float)__builtin_bit_cast(h16x2_t, w)[0]; }
__device__ __forceinline__ float unpkh_hi(unsigned w) { return (float)__builtin_bit_cast(h16x2_t, w)[1]; }
#if MK_F16
__device__ __forceinline__ unsigned pk16(float lo, float hi) { unsigned r; asm volatile("v_cvt_pk_f16_f32 %0, %1, %2" : "=v"(r) : "v"(lo), "v"(hi)); return r; }
__device__ __forceinline__ float unpk_lo(unsigned w) { return (float)__builtin_bit_cast(h16x2_t, w)[0]; }
__device__ __forceinline__ float unpk_hi(unsigned w) { return (float)__builtin_bit_cast(h16x2_t, w)[1]; }
__device__ __forceinline__ f32x4_t mfma16(s16x8_t a, s16x8_t b, f32x4_t c, int, int, int) { return __builtin_amdgcn_mfma_f32_16x16x32_f16(__builtin_bit_cast(h16x8_t, a), __builtin_bit_cast(h16x8_t, b), c, 0, 0, 0); }
#else
__device__ __forceinline__ unsigned pk16(float lo, float hi) { unsigned r; asm volatile("v_cvt_pk_bf16_f32 %0, %1, %2" : "=v"(r) : "v"(lo), "v"(hi)); return r; }
__device__ __forceinline__ float unpk_lo(unsigned w) { return __uint_as_float(w << 16); }
__device__ __forceinline__ float unpk_hi(unsigned w) { return __uint_as_float(w & 0xffff0000u); }
__device__ __forceinline__ f32x4_t mfma16(s16x8_t a, s16x8_t b, f32x4_t c, int, int, int) { return __builtin_amdgcn_mfma_f32_16x16x32_bf16(a, b, c, 0, 0, 0); }
#endif
namespace pg8 {
#define PG8_LAS __attribute__((address_space(3)))
typedef unsigned short bf16_t;
typedef short bf16x8 __attribute__((ext_vector_type(8)));
typedef float f32x4 __attribute__((ext_vector_type(4)));
typedef unsigned u32x4 __attribute__((ext_vector_type(4)));
constexpr int BM = 256, BK = 64, HALF = 128, HTB = HALF * BK * 2  , STAGE_BYTES = 8 * HTB, NXCD = 8, WGM = 4;

__host__ __device__ __forceinline__ int lds_byte(int r, int c) { const int st = (r >> 4) * 2 + (c >> 5), rr = r & 15, cc = c & 31, ob = rr * 64 + cc * 2; return st * 1024 + (ob ^ (((ob >> 9) & 1) << 5)); }
__host__ __device__ __forceinline__ void stage_rc(int b, int& R, int& C) { const int st = b / 1024, sb = b % 1024, swz = sb ^ (((sb >> 9) & 1) << 5); R = (st >> 1) * 16 + swz / 64; C = (st & 1) * 32 + (swz % 64) / 2; }
__host__ __device__ __forceinline__ int perm32(int rho) { const int n = rho >> 4, i = rho & 15; return 8 * (i >> 2) + 4 * n + (i & 3); }

struct Unit { int pm, pn, kp, slot; };
struct Gemm { const bf16_t* A; const bf16_t* Bt; int M, N, K, nt; };

struct StaticOrder {
    int nM, nN, nwg, G, c, limit;
    __host__ __device__ void init(int M, int N, int G_, int c_) { nM = M / BM; nN = N / BM; nwg = nM * nN; G = G_; c = c_; limit = nwg; }
    __host__ __device__ void map(int L, Unit& u) const {
        int wgid = L; { const int q = nwg / NXCD, r = nwg % NXCD, xcd = wgid % NXCD, off = wgid / NXCD; wgid = (xcd < r ? xcd * (q + 1) : r * (q + 1) + (xcd - r) * q) + off; }
        const int nig = WGM * nN, gid = wgid / nig, fm = gid * WGM, gsz = (nM - fm) < WGM ? (nM - fm) : WGM;
        u.pm = fm + ((wgid % nig) % gsz); u.pn = (wgid % nig) / gsz; u.kp = 0; u.slot = 0;
    }
    __host__ __device__ bool next(int i, Unit& u) const {
        const long L = (long)i * G + c; if (L >= limit) return false;
        map((int)L, u); u.slot = i; return true;
    }
    __device__ __forceinline__ void a_ready(const Unit&) const {}
    __device__ __forceinline__ void done(const Unit&) const {}
};
struct SplitOrder {
    StaticOrder base; int L0, S, ntiles, kvmode, c;
    __device__ bool next(int i, Unit& u) const {
        if (i > 0) return false;
        const int slot = (c / (8 * S)) * 8 + (c & 7); if (slot >= ntiles) return false;
        if (kvmode) { u.pm = slot >> 1; u.pn = 8 + (slot & 1); } else base.map(L0 + slot, u);
        u.kp = (c >> 3) % S; u.slot = slot; return true;
    }
    __device__ __forceinline__ void a_ready(const Unit&) const {}
    __device__ __forceinline__ void done(const Unit&) const {}
};

__device__ __forceinline__ unsigned cvt_pk_bf16(float lo, float hi) { return pk16(lo, hi); }
typedef float f32x2 __attribute__((ext_vector_type(2)));
__device__ __forceinline__ float fast_sigmoid_mul(float x, float z) {   return x * __builtin_amdgcn_rcpf(1.0f + __builtin_amdgcn_exp2f(z * -1.4426950408889634f)); }
__device__ __forceinline__ float gelu_tanh(float x) { const float y2 = x * (1.5957691216057308f + 0.07135481627f * x * x); return fast_sigmoid_mul(x, y2); }
__device__ __forceinline__ float silu_f(float x) { return fast_sigmoid_mul(x, x); }
__device__ __forceinline__ void row_rstd(const float* stats, int row0, int fq, float (&rs)[2][4]) {
#pragma unroll
    for (int ai = 0; ai < 2; ++ai) {
        f32x4 pa[4], pb[4];
#pragma unroll
        for (int m = 0; m < 4; ++m) { const f32x4* p = (const f32x4*)(stats + (size_t)(row0 + ai * HALF + m * 16) * 32 + fq * 8); pa[m] = p[0]; pb[m] = p[1]; }
#pragma unroll
        for (int m = 0; m < 4; ++m) {
            const f32x4 a = pa[m], b = pb[m];
            float s = ((a[0] + a[1]) + (a[2] + a[3])) + ((b[0] + b[1]) + (b[2] + b[3]));
            s += __shfl_xor(s, 16); s += __shfl_xor(s, 32);
            rs[ai][m] = rsqrtf(s * (1.0f / 2048.0f) + 1e-5f);
        }
    }
}
__device__ __forceinline__ void row_rstd2(const float* stats, int row0, int fq, float (&rs)[2][4], float (&ms)[2][4]) {
#pragma unroll
    for (int ai = 0; ai < 2; ++ai) {
        f32x4 pa[4], pb[4];
#pragma unroll
        for (int m = 0; m < 4; ++m) { const f32x4* p = (const f32x4*)(stats + (size_t)(row0 + ai * HALF + m * 16) * 32 + fq * 8); pa[m] = p[0]; pb[m] = p[1]; }
#pragma unroll
        for (int m = 0; m < 4; ++m) {
            const f32x4 a = pa[m], b = pb[m];
            float s = ((a[0] + a[1]) + (a[2] + a[3])) + ((b[0] + b[1]) + (b[2] + b[3]));
            s += __shfl_xor(s, 16); s += __shfl_xor(s, 32);
            ms[ai][m] = s * (1.0f / 2048.0f) + 1e-5f; rs[ai][m] = rsqrtf(ms[ai][m]);
        }
    }
}
__device__ __forceinline__ void build_ms_table(PG8_LAS float* tab, const float* stats, const StaticOrder& S) {
    const int tid = opaque_tid(), row = tid >> 1, half = tid & 1;
    Unit u0, u; const bool any = S.next(0, u0); if (!any) return;
    f32x4 v[6][4];
#pragma unroll
    for (int i = 0; i < 6; ++i) {
        if (!S.next(i, u)) u = u0;
        const f32x4* p = (const f32x4*)(stats + (size_t)(u.pm * BM + row) * 32 + half * 16);
#pragma unroll
        for (int k = 0; k < 4; ++k) v[i][k] = p[k];
    }
#pragma unroll
    for (int i = 0; i < 6; ++i) {
        float sm = 0.f;
#pragma unroll
        for (int k = 0; k < 4; ++k) sm += (v[i][k][0] + v[i][k][1]) + (v[i][k][2] + v[i][k][3]);
        sm += __shfl_xor(sm, 1);
        if (half == 0) tab[i * BM + row] = sm * (1.0f / 2048.0f) + 1e-5f;
    }
}
__device__ __forceinline__ void tab_rstd(const PG8_LAS float* tab, const Unit& u, int wr, int fr, float (&rs)[2][4], float (&ms)[2][4]) {
#pragma unroll
    for (int ai = 0; ai < 2; ++ai)
#pragma unroll
        for (int m = 0; m < 4; ++m) { ms[ai][m] = tab[u.slot * BM + ai * HALF + wr * 64 + m * 16 + fr]; rs[ai][m] = rsqrtf(ms[ai][m]); }
}
__device__ __forceinline__ u32x4 pack8(const f32x4 v0, const f32x4 v1) { u32x4 w; w.x = cvt_pk_bf16(v0[0], v0[1]); w.y = cvt_pk_bf16(v0[2], v0[3]); w.z = cvt_pk_bf16(v1[0], v1[1]); w.w = cvt_pk_bf16(v1[2], v1[3]); return w; }
__device__ __forceinline__ float sq8(const f32x4 v0, const f32x4 v1) { return ((v0[0] * v0[0] + v0[1] * v0[1]) + (v0[2] * v0[2] + v0[3] * v0[3])) + ((v1[0] * v1[0] + v1[1] * v1[1]) + (v1[2] * v1[2] + v1[3] * v1[3])); }

struct EpiGeluUV {
    static constexpr bool PERM = true, AFTER_DRAIN = false;
    bf16_t* U; bf16_t* V; const float* hstats; float* vstats; const PG8_LAS float* tab;
    __device__ __forceinline__ void operator()(const f32x4 (&acc)[2][2][4][2], const Unit& u, int wr, int wc, int fr, int fq) const {
        const int row0 = u.pm * BM + wr * 64 + fr;
        float rs[2][4], ms_[2][4]; tab_rstd(tab, u, wr, fr, rs, ms_);
        const bool isv = u.pn >= 8; const int ct = isv ? u.pn - 8 : u.pn;
        bf16_t* base = isv ? V : U; const int col0 = ct * BM + wc * 32 + 8 * fq;
#pragma unroll
        for (int ai = 0; ai < 2; ++ai)
#pragma unroll
            for (int m = 0; m < 4; ++m) {
                const int row = row0 + ai * HALF + m * 16; const float r = rs[ai][m]; float ss = 0.f;
#pragma unroll
                for (int bj = 0; bj < 2; ++bj) {
                    f32x4 v0 = acc[ai][bj][m][0] * r, v1 = acc[ai][bj][m][1] * r;
#pragma unroll
                    for (int e = 0; e < 4; ++e) { v0[e] = gelu_tanh(v0[e]); v1[e] = gelu_tanh(v1[e]); }
                    ss += sq8(v0, v1);
                    *(u32x4*)(base + (size_t)row * 2048 + col0 + bj * HALF) = pack8(v0, v1);
                }
                if (isv) { ss += __shfl_xor(ss, 16); ss += __shfl_xor(ss, 32); if (fq == 0) vstats[(size_t)row * 32 + ct * 4 + wc] = ss; }
            }
    }
};
__device__ __forceinline__ void bf8_to_f32(const u32x4 w, f32x4& a, f32x4& b) {
    a[0] = unpk_lo(w.x); a[1] = unpk_hi(w.x); a[2] = unpk_lo(w.y); a[3] = unpk_hi(w.y);
    b[0] = unpk_lo(w.z); b[1] = unpk_hi(w.z); b[2] = unpk_lo(w.w); b[3] = unpk_hi(w.w);
}
__device__ __forceinline__ void h8_to_f32(const u32x4 w, f32x4& a, f32x4& b) {
    a[0] = unpkh_lo(w.x); a[1] = unpkh_hi(w.x); a[2] = unpkh_lo(w.y); a[3] = unpkh_hi(w.y);
    b[0] = unpkh_lo(w.z); b[1] = unpkh_hi(w.z); b[2] = unpkh_lo(w.w); b[3] = unpkh_hi(w.w);
}
struct EpiResid {
    static constexpr bool PERM = true, AFTER_DRAIN = false;
    float* H; bf16_t* HB; float* hstats; const float* bias; const float* Hin;
    bf16_t* LO;
    __device__ __forceinline__ void operator()(const f32x4 (&acc)[2][2][4][2], const Unit& u, int wr, int wc, int fr, int fq) const {
        const int row0 = u.pm * BM + wr * 64 + fr; const int col0 = u.pn * BM + wc * 32 + 8 * fq;
        f32x4 bv[2][2];
#pragma unroll
        for (int bj = 0; bj < 2; ++bj)
#pragma unroll
            for (int n = 0; n < 2; ++n) bv[bj][n] = bias ? *(const f32x4*)(bias + col0 + bj * HALF + 4 * n) : (f32x4){0.f, 0.f, 0.f, 0.f};
        if (Hin) {
            f32x4 hv[3][2][2];
#define RESID_LOAD(buf, g) do { _Pragma("unroll") for (int bj = 0; bj < 2; ++bj) { \
            const float* hp_ = Hin + (size_t)(row0 + ((g) >> 2) * HALF + ((g) & 3) * 16) * 2048 + col0 + bj * HALF; hv[buf][bj][0] = *(const f32x4*)hp_; hv[buf][bj][1] = *(const f32x4*)(hp_ + 4); } } while (0)
            RESID_LOAD(0, 0); RESID_LOAD(1, 1);
#pragma unroll
            for (int g = 0; g < 8; ++g) {
                const int ai = g >> 2, m = g & 3;
                if (g + 2 < 8) RESID_LOAD((g + 2) % 3, g + 2);
                const int row = row0 + ai * HALF + m * 16; float ss = 0.f;
#pragma unroll
                for (int bj = 0; bj < 2; ++bj) {
                    f32x4 h0 = hv[g % 3][bj][0], h1 = hv[g % 3][bj][1];
                    h0 = h0 + (acc[ai][bj][m][0] + bv[bj][0]); h1 = h1 + (acc[ai][bj][m][1] + bv[bj][1]);
                    store_h(row, col0 + bj * HALF, h0, h1);
                    ss += sq8(h0, h1);
                }
                ss += __shfl_xor(ss, 16); ss += __shfl_xor(ss, 32);
                if (fq == 0) hstats[(size_t)row * 32 + u.pn * 4 + wc] = ss;
            }
#undef RESID_LOAD
        } else {
            constexpr int NB = (MK_RESID == 2) ? 2 : 3;
            u32x4 hv[NB][2][2];
#define RESID_LOAD(buf, g) do { _Pragma("unroll") for (int bj = 0; bj < 2; ++bj) { \
            const size_t o_ = (size_t)(row0 + ((g) >> 2) * HALF + ((g) & 3) * 16) * 2048 + col0 + bj * HALF; hv[buf][bj][0] = *(const u32x4*)((MK_RESID == 3 ? LO : HB) + o_); if (MK_RESID == 2) hv[buf][bj][1] = *(const u32x4*)(LO + o_); } } while (0)
            RESID_LOAD(0, 0); if (NB == 3) RESID_LOAD(1, 1);
#pragma unroll
            for (int g = 0; g < 8; ++g) {
                const int ai = g >> 2, m = g & 3;
                if (g + NB - 1 < 8) RESID_LOAD((g + NB - 1) % NB, g + NB - 1);
                const int row = row0 + ai * HALF + m * 16; float ss = 0.f;
#pragma unroll
                for (int bj = 0; bj < 2; ++bj) {
                    f32x4 h0, h1; if (MK_RESID == 3) h8_to_f32(hv[g % NB][bj][0], h0, h1); else bf8_to_f32(hv[g % NB][bj][0], h0, h1);
                    if (MK_RESID == 2) { f32x4 l0, l1; bf8_to_f32(hv[g % NB][bj][1], l0, l1); h0 = h0 + l0; h1 = h1 + l1; }
                    h0 = h0 + (acc[ai][bj][m][0] + bv[bj][0]); h1 = h1 + (acc[ai][bj][m][1] + bv[bj][1]);
                    store_h(row, col0 + bj * HALF, h0, h1);
                    ss += sq8(h0, h1);
                }
                ss += __shfl_xor(ss, 16); ss += __shfl_xor(ss, 32);
                if (fq == 0) hstats[(size_t)row * 32 + u.pn * 4 + wc] = ss;
            }
#undef RESID_LOAD
        }
    }
    __device__ __forceinline__ void store_h(int row, int col, const f32x4 h0, const f32x4 h1) const {
        const size_t o = (size_t)row * 2048 + col;
        const u32x4 hi = pack8(h0, h1);
        *(u32x4*)(HB + o) = hi;
        if (MK_RESID == 0) { *(f32x4*)(H + o) = h0; *(f32x4*)(H + o + 4) = h1; }
        if (MK_RESID == 2) { f32x4 a, b; bf8_to_f32(hi, a, b); *(u32x4*)(LO + o) = pack8(h0 - a, h1 - b); }
        if (MK_RESID == 3) { u32x4 w; w.x = pkh16(h0[0], h0[1]); w.y = pkh16(h0[2], h0[3]); w.z = pkh16(h1[0], h1[1]); w.w = pkh16(h1[2], h1[3]); *(u32x4*)(LO + o) = w; }
    }
};
struct EpiSwiglu {
    static constexpr bool PERM = true, AFTER_DRAIN = false;
    bf16_t* ACT; const float* hstats; const PG8_LAS float* tab;
    __device__ __forceinline__ void operator()(const f32x4 (&acc)[2][2][4][2], const Unit& u, int wr, int wc, int fr, int fq) const { run(acc, u, wr, wc, fr, fq, 3, 3); }
    __device__ __forceinline__ void run(const f32x4 (&acc)[2][2][4][2], const Unit& u, int wr, int wc, int fr, int fq, int aimask, int  ) const {
        const int row0 = u.pm * BM + wr * 64 + fr; const int col0 = u.pn * HALF + wc * 32 + 8 * fq;
        float rs[2][4], ms[2][4]; if (tab) tab_rstd(tab, u, wr, fr, rs, ms); else row_rstd2(hstats, row0, fq, rs, ms);
#pragma unroll
        for (int ai = 0; ai < 2; ++ai) {
            if (!((aimask >> ai) & 1)) continue;
#pragma unroll
            for (int m = 0; m < 4; ++m) {
                const int row = row0 + ai * HALF + m * 16; const float rn = rs[ai][m] * -1.4426950408889634f, mq = ms[ai][m];
                f32x4 g0 = acc[ai][0][m][0], g1 = acc[ai][0][m][1]; const f32x4 u0 = acc[ai][1][m][0], u1 = acc[ai][1][m][1];
#pragma unroll
                for (int e = 0; e < 4; ++e) {
                    const float e0 = __builtin_amdgcn_exp2f(g0[e] * rn), e1 = __builtin_amdgcn_exp2f(g1[e] * rn);
                    g0[e] = (g0[e] * u0[e]) * __builtin_amdgcn_rcpf(__builtin_fmaf(e0, mq, mq)); g1[e] = (g1[e] * u1[e]) * __builtin_amdgcn_rcpf(__builtin_fmaf(e1, mq, mq));
                }
                *(u32x4*)(ACT + (size_t)row * 5632 + col0) = pack8(g0, g1);
            }
        }
    }
};
struct EpiQKV {
    static constexpr bool PERM = true, AFTER_DRAIN = false;
    bf16_t* Q; bf16_t* KV; const float* hstats; const float* bq; const float* bkv; float qscale; const PG8_LAS float* tab;
    __device__ __forceinline__ void operator()(const f32x4 (&acc)[2][2][4][2], const Unit& u, int wr, int wc, int fr, int fq) const { run(acc, u, wr, wc, fr, fq, 3, 3); }
    __device__ __forceinline__ void run(const f32x4 (&acc)[2][2][4][2], const Unit& u, int wr, int wc, int fr, int fq, int aimask, int bjmask) const {
        const int row0 = u.pm * BM + wr * 64 + fr;
        float rs[2][4], ms_[2][4]; if (tab) tab_rstd(tab, u, wr, fr, rs, ms_); else row_rstd(hstats, row0, fq, rs);
        const bool isq = u.pn < 8; const int ct = isq ? u.pn : u.pn - 8; const int ldc = isq ? 2048 : 512;
        bf16_t* base = isq ? Q : KV; const float* bias = isq ? bq : bkv; const float sc = isq ? qscale : 1.0f;
        const int col0 = ct * BM + wc * 32 + 8 * fq;
        f32x4 bv[2][2];
#pragma unroll
        for (int bj = 0; bj < 2; ++bj)
#pragma unroll
            for (int n = 0; n < 2; ++n) bv[bj][n] = *(const f32x4*)(bias + col0 + bj * HALF + 4 * n);
#pragma unroll
        for (int ai = 0; ai < 2; ++ai) {
            if (!((aimask >> ai) & 1)) continue;
#pragma unroll
            for (int m = 0; m < 4; ++m) {
                const int row = row0 + ai * HALF + m * 16; const float r = rs[ai][m];
#pragma unroll
                for (int bj = 0; bj < 2; ++bj) {
                    if (!((bjmask >> bj) & 1)) continue;
                    const f32x4 v0 = (acc[ai][bj][m][0] * r + bv[bj][0]) * sc, v1 = (acc[ai][bj][m][1] * r + bv[bj][1]) * sc;
                    *(u32x4*)(base + (size_t)row * ldc + col0 + bj * HALF) = pack8(v0, v1);
                }
            }
        }
    }
};

struct EpiStore {
    static constexpr bool PERM = true, AFTER_DRAIN = true;
    float* xbuf; unsigned* flags; int S;
    __device__ __forceinline__ void fused(f32x4 (&acc)[2][2][4][2], const Unit& u, int wr, int wc, int fr, int fq, PG8_LAS unsigned char* lds, int wid, int lane) const {
        typedef __attribute__((address_space(1))) unsigned gu32;
        const int tid = wid * 64 + lane;
        const f32x4* dst = (const f32x4*)xbuf + ((size_t)(u.slot * S + u.kp) * 32) * 512 + tid;
#pragma unroll
        for (int ai = 0; ai < 2; ++ai)
#pragma unroll
            for (int bj = 0; bj < 2; ++bj)
#pragma unroll
                for (int m = 0; m < 4; ++m)
#pragma unroll
                    for (int n = 0; n < 2; ++n) {
                        const f32x4 v = acc[ai][bj][m][n]; const f32x4* d = dst + (size_t)(((ai * 2 + bj) * 4 + m) * 2 + n) * 512;
                        asm volatile("global_store_dwordx4 %0, %1, off sc1" :: "v"(d), "v"(v) : "memory");
                    }
        asm volatile("s_waitcnt vmcnt(0)" ::: "memory");
        __syncthreads();
        if (tid == 0) __hip_atomic_fetch_add((gu32*)(flags + u.slot), 1u, __ATOMIC_RELAXED, __HIP_MEMORY_SCOPE_AGENT);
    }
};
template <class Inner> __device__ __forceinline__ void split_fixup(const Inner& inner, const float* xbuf, unsigned* flags, int S, const Unit& u) {
    typedef __attribute__((address_space(1))) unsigned gu32;
    const int tid = opaque_tid(), wid = tid >> 6, lane = tid & 63, wr = wid >> 2, wc = wid & 3, fr = lane & 15, fq = lane >> 4;
    if (tid == 0) {
        unsigned sp = 0;
        while (__hip_atomic_load((gu32*)(flags + u.slot), __ATOMIC_RELAXED, __HIP_MEMORY_SCOPE_AGENT) < (unsigned)S) { __builtin_amdgcn_s_sleep(2); if (++sp > (1u << 22)) break; }
        __builtin_amdgcn_fence(__ATOMIC_ACQUIRE, "agent");
        asm volatile("s_waitcnt vmcnt(0)" ::: "memory");
    }
    __syncthreads();
    const int aimask = (S == 2) ? (1 << u.kp) : (1 << (u.kp >> 1)), bjmask = (S == 2) ? 3 : (1 << (u.kp & 1));
    f32x4 acc[2][2][4][2];
#pragma unroll
    for (int ai = 0; ai < 2; ++ai)
#pragma unroll
        for (int bj = 0; bj < 2; ++bj)
#pragma unroll
            for (int m = 0; m < 4; ++m)
#pragma unroll
                for (int n = 0; n < 2; ++n) acc[ai][bj][m][n] = (f32x4){0.f, 0.f, 0.f, 0.f};
    for (int h = 0; h < S; ++h) {
        const f32x4* src = (const f32x4*)xbuf + ((size_t)(u.slot * S + h) * 32) * 512 + tid;
#pragma unroll
        for (int ai = 0; ai < 2; ++ai) {
            if (!((aimask >> ai) & 1)) continue;
#pragma unroll
            for (int bj = 0; bj < 2; ++bj) {
                if (!((bjmask >> bj) & 1)) continue;
                f32x4 t[4][2];
#pragma unroll
                for (int m = 0; m < 4; ++m)
#pragma unroll
                    for (int n = 0; n < 2; ++n) t[m][n] = src[(size_t)(((ai * 2 + bj) * 4 + m) * 2 + n) * 512];
#pragma unroll
                for (int m = 0; m < 4; ++m)
#pragma unroll
                    for (int n = 0; n < 2; ++n) acc[ai][bj][m][n] = acc[ai][bj][m][n] + t[m][n];
            }
        }
    }
    inner.run(acc, u, wr, wc, fr, fq, aimask, bjmask);
}

template <class Epi, class Sched, bool ALIGN_EPI = false, bool SP2 = false>
__device__ __forceinline__ void gemm_phase(PG8_LAS unsigned char* lds, const Gemm g, const Sched& S, const Epi& E) {
    const int tid = opaque_tid(), wid = __builtin_amdgcn_readfirstlane(tid >> 6), lane = tid & 63, wr = wid >> 2, wc = wid & 3, fr = lane & 15, fq = lane >> 4;
    const int K = g.K, nt = g.nt;
    unsigned voffA[2], voffB[2];
#pragma unroll
    for (int i = 0; i < 2; ++i) { int R, C; stage_rc(tid * 16 + i * 8192, R, C); const int Rb = Epi::PERM ? ((R & ~31) + perm32(R & 31)) : R;
        voffA[i] = (unsigned)(R * K + C) * 2u; voffB[i] = (unsigned)(Rb * K + C) * 2u; }
    const size_t kstep = (size_t)(BK * 2);
    const size_t hstep = (size_t)HALF * K * 2;
    const size_t tstep = 2 * hstep;
    const unsigned ldsw = (unsigned)wid * 1024u;
    const int aoff = lds_byte(wr * 64 + fr, fq * 8), boff = lds_byte(wc * 32 + fr, fq * 8);
#define PG8_SA(b, h) (((b) * 2 + (h)) * HTB)
#define PG8_SB(b, h) ((4 + (b) * 2 + (h)) * HTB)
#define PG8_STAGE(bufoff, gbase, voff) do { _Pragma("unroll") for (int _i = 0; _i < 2; ++_i) \
        __builtin_amdgcn_global_load_lds((const unsigned*)((const char*)(gbase) + (voff)[_i]), (PG8_LAS unsigned*)(lds + (bufoff) + ldsw + _i * 8192), 16, 0, 0); } while (0)
#define PG8_LDA(dst, b, h) do { _Pragma("unroll") for (int m = 0; m < 4; ++m) _Pragma("unroll") for (int k = 0; k < 2; ++k) dst[m][k] = *(const PG8_LAS bf16x8*)(lds + PG8_SA(b, h) + aoff + m * 2048 + k * 1024); } while (0)
#define PG8_LDB(dst, b, h) do { _Pragma("unroll") for (int n = 0; n < 2; ++n) _Pragma("unroll") for (int k = 0; k < 2; ++k) dst[n][k] = *(const PG8_LAS bf16x8*)(lds + PG8_SB(b, h) + boff + n * 2048 + k * 1024); } while (0)
#define PG8_MMA(ai, bj, At, Bt) do { __builtin_amdgcn_s_setprio(1); _Pragma("unroll") for (int m = 0; m < 4; ++m) _Pragma("unroll") for (int n = 0; n < 2; ++n) _Pragma("unroll") for (int k = 0; k < 2; ++k) \
        acc[ai][bj][m][n] = mfma16(Bt[n][k], At[m][k], acc[ai][bj][m][n], 0, 0, 0); __builtin_amdgcn_s_setprio(0); } while (0)
#define PG8_WAIT_V(n) asm volatile("s_waitcnt vmcnt(" #n ")" ::: "memory")
#define PG8_WAIT_L(n) asm volatile("s_waitcnt lgkmcnt(" #n ")" ::: "memory")
#define PG8_BAR __builtin_amdgcn_s_barrier()
#define PG8_SCHED __builtin_amdgcn_sched_barrier(0)
    Unit cur, nxt; int ui = 0;
    if (!S.next(0, cur)) return;
    f32x4 acc[2][2][4][2];
#pragma unroll
    for (int a = 0; a < 2; ++a)
#pragma unroll
        for (int b = 0; b < 2; ++b)
#pragma unroll
            for (int m = 0; m < 4; ++m)
#pragma unroll
                for (int n = 0; n < 2; ++n) acc[a][b][m][n] = (f32x4){0.f, 0.f, 0.f, 0.f};
    bf16x8 At[4][2], B0[2][2], B1[2][2];
    const size_t kpstep = (size_t)nt * kstep;
    const char* cA = (const char*)g.A + (size_t)cur.pm * tstep + (size_t)cur.kp * kpstep; const char* cB = (const char*)g.Bt + (size_t)cur.pn * tstep + (size_t)cur.kp * kpstep;
    S.a_ready(cur);
    if constexpr (SP2) {
        PG8_STAGE(PG8_SB(0, 0), cB, voffB); PG8_STAGE(PG8_SB(0, 1), cB + hstep, voffB); PG8_STAGE(PG8_SA(0, 0), cA, voffA); PG8_STAGE(PG8_SA(0, 1), cA + hstep, voffA);
        if (wr == 1) PG8_BAR;
        PG8_WAIT_V(2); PG8_BAR;
        PG8_STAGE(PG8_SB(1, 0), cB + kstep, voffB); PG8_STAGE(PG8_SA(1, 0), cA + kstep, voffA); PG8_STAGE(PG8_SB(1, 1), cB + hstep + kstep, voffB);
        PG8_WAIT_V(6); PG8_BAR;
    } else {
        PG8_STAGE(PG8_SB(0, 0), cB, voffB); PG8_STAGE(PG8_SA(0, 0), cA, voffA); PG8_STAGE(PG8_SB(0, 1), cB + hstep, voffB); PG8_STAGE(PG8_SA(0, 1), cA + hstep, voffA);
        if (wr == 1) PG8_BAR;
        PG8_WAIT_V(4); PG8_BAR;
        PG8_STAGE(PG8_SB(1, 0), cB + kstep, voffB); PG8_STAGE(PG8_SA(1, 0), cA + kstep, voffA); PG8_STAGE(PG8_SB(1, 1), cB + hstep + kstep, voffB);
        PG8_WAIT_V(6); PG8_BAR;
    }
    for (;;) {
        const bool has_next = S.next(ui + 1, nxt);
        const char* nA = has_next ? (const char*)g.A + (size_t)nxt.pm * tstep + (size_t)nxt.kp * kpstep : cA; const char* nB = has_next ? (const char*)g.Bt + (size_t)nxt.pn * tstep + (size_t)nxt.kp * kpstep : cB;
        for (int t = 0; t < nt; t += 2) {
            const bool last = (t == nt - 2);
            const char* a1 = cA + (size_t)(t + 1) * kstep;
            const char* a2 = last ? nA : cA + (size_t)(t + 2) * kstep; const char* b2 = last ? nB : cB + (size_t)(t + 2) * kstep;
            const char* a3 = a2 + kstep; const char* b3 = b2 + kstep;
            if (last && has_next) S.a_ready(nxt);
            if constexpr (SP2) {
            PG8_LDB(B0, 0, 0); PG8_LDB(B1, 0, 1); PG8_SCHED; PG8_LDA(At, 0, 0); PG8_STAGE(PG8_SA(1, 1), a1 + hstep, voffA);
            PG8_WAIT_V(8); PG8_WAIT_L(0); PG8_BAR; PG8_MMA(0, 0, At, B0); PG8_MMA(0, 1, At, B1); PG8_BAR; PG8_SCHED;
            PG8_LDA(At, 0, 1); PG8_STAGE(PG8_SB(0, 0), b2, voffB); PG8_STAGE(PG8_SB(0, 1), b2 + hstep, voffB); PG8_STAGE(PG8_SA(0, 0), a2, voffA);
            PG8_WAIT_V(8); PG8_WAIT_L(0); PG8_BAR; PG8_MMA(1, 0, At, B0); PG8_MMA(1, 1, At, B1); PG8_BAR; PG8_SCHED;
            PG8_LDB(B0, 1, 0); PG8_LDB(B1, 1, 1); PG8_SCHED; PG8_LDA(At, 1, 0); PG8_STAGE(PG8_SA(0, 1), a2 + hstep, voffA);
            PG8_WAIT_V(8); PG8_WAIT_L(0); PG8_BAR; PG8_MMA(0, 0, At, B0); PG8_MMA(0, 1, At, B1); PG8_BAR; PG8_SCHED;
            PG8_LDA(At, 1, 1); PG8_STAGE(PG8_SB(1, 0), b3, voffB); PG8_STAGE(PG8_SB(1, 1), b3 + hstep, voffB); PG8_STAGE(PG8_SA(1, 0), a3, voffA);
            PG8_WAIT_V(8); PG8_WAIT_L(0); PG8_BAR; PG8_MMA(1, 0, At, B0); PG8_MMA(1, 1, At, B1); PG8_BAR; PG8_SCHED;
            } else {
            PG8_LDB(B0, 0, 0); PG8_SCHED; PG8_LDA(At, 0, 0); PG8_STAGE(PG8_SA(1, 1), a1 + hstep, voffA);
            PG8_WAIT_L(8); PG8_BAR; PG8_WAIT_L(0); PG8_MMA(0, 0, At, B0); PG8_BAR; PG8_SCHED;
            PG8_LDB(B1, 0, 1); PG8_STAGE(PG8_SB(0, 0), b2, voffB);
            PG8_BAR; PG8_WAIT_L(0); PG8_MMA(0, 1, At, B1); PG8_BAR;
            PG8_LDA(At, 0, 1); PG8_STAGE(PG8_SA(0, 0), a2, voffA);
            PG8_BAR; PG8_WAIT_L(0); PG8_MMA(1, 0, At, B0); PG8_BAR; PG8_SCHED;
            PG8_STAGE(PG8_SB(0, 1), b2 + hstep, voffB);
            PG8_WAIT_V(6); PG8_BAR; PG8_MMA(1, 1, At, B1); PG8_BAR;
            PG8_LDB(B0, 1, 0); PG8_SCHED; PG8_LDA(At, 1, 0); PG8_STAGE(PG8_SA(0, 1), a2 + hstep, voffA);
            PG8_WAIT_L(8); PG8_BAR; PG8_WAIT_L(0); PG8_MMA(0, 0, At, B0); PG8_BAR; PG8_SCHED;
            PG8_LDB(B1, 1, 1); PG8_STAGE(PG8_SB(1, 0), b3, voffB);
            PG8_BAR; PG8_WAIT_L(0); PG8_MMA(0, 1, At, B1); PG8_BAR;
            PG8_LDA(At, 1, 1); PG8_STAGE(PG8_SA(1, 0), a3, voffA);
            PG8_BAR; PG8_WAIT_L(0); PG8_MMA(1, 0, At, B0); PG8_BAR; PG8_SCHED;
            PG8_STAGE(PG8_SB(1, 1), b3 + hstep, voffB);
            PG8_WAIT_V(6); PG8_BAR; PG8_MMA(1, 1, At, B1); PG8_BAR;
            }
        }
        if constexpr (ALIGN_EPI) { if (wr == 0) PG8_BAR; }
        if constexpr (!Epi::AFTER_DRAIN) { E(acc, cur, wr, wc, fr, fq); S.done(cur); }
        if (!has_next) break;
#pragma unroll
        for (int a = 0; a < 2; ++a)
#pragma unroll
            for (int b = 0; b < 2; ++b)
#pragma unroll
                for (int m = 0; m < 4; ++m)
#pragma unroll
                    for (int n = 0; n < 2; ++n) acc[a][b][m][n] = (f32x4){0.f, 0.f, 0.f, 0.f};
        cur = nxt; cA = nA; cB = nB; ++ui;
        if constexpr (ALIGN_EPI) { if (wr == 1) PG8_BAR; }
    }
    PG8_WAIT_V(0);
    if constexpr (!ALIGN_EPI) { if (wr == 0) PG8_BAR; }
    PG8_BAR;
    if constexpr (Epi::AFTER_DRAIN) { E.fused(acc, cur, wr, wc, fr, fq, lds, wid, lane); S.done(cur); }
#undef PG8_SA
#undef PG8_SB
#undef PG8_STAGE
#undef PG8_LDA
#undef PG8_LDB
#undef PG8_MMA
#undef PG8_WAIT_V
#undef PG8_WAIT_L
#undef PG8_BAR
#undef PG8_SCHED
}
}

constexpr int M = 8192, DM = 2048, SEQ = 2048, DFF = 5632, NH = 32, NKV = 4, HD = 64;
constexpr int NWAVES = 8, NTHREADS = 512;
constexpr size_t MiB = 1u << 20;
constexpr size_t WS_HSTAT = 1 * MiB, WS_VSTAT = 2 * MiB;
constexpr size_t WS_AIN = 4 * MiB;
constexpr size_t WS_AOUT = 36 * MiB;
constexpr size_t WS_FUP = 52 * MiB;
constexpr size_t WS_FDN = 228 * MiB;
constexpr size_t WS_Q0 = 316 * MiB;
constexpr size_t WS_Q1 = 326 * MiB;
constexpr size_t WS_WO = 334 * MiB;
constexpr size_t WS_HB = 350 * MiB;
constexpr size_t WS_B1 = 382 * MiB;
constexpr size_t WS_B2 = 414 * MiB;
constexpr size_t WS_B3 = 446 * MiB;
constexpr size_t WS_ACT = 478 * MiB;
constexpr size_t WS_KV = 566 * MiB;
constexpr size_t WS_LO = 638 * MiB;
constexpr size_t WS_XB = 574 * MiB;
constexpr size_t WS_END = 670 * MiB;
constexpr size_t CTL_FLAGS = 32768;
constexpr int LDS_BYTES = 147456;
constexpr int N_PHASES = 22;
constexpr int TAB_OFF = 131072;
constexpr int MISC_OFF = 140 * 1024;
constexpr size_t CTL_ZERO_BYTES = 65536;

#define LAS __attribute__((address_space(3)))
#define KAS __attribute__((address_space(4)))
typedef const float* cfp;
typedef const KAS cfp* kin_t;
typedef unsigned short bf16;
typedef unsigned v4u __attribute__((ext_vector_type(4)));
typedef unsigned v2u __attribute__((ext_vector_type(2)));
typedef float f32x4 __attribute__((ext_vector_type(4)));
typedef short bf16x8 __attribute__((ext_vector_type(8)));
#define LDS_WAIT() asm volatile("s_waitcnt lgkmcnt(0)" ::: "memory")
__device__ __forceinline__ unsigned pk2(float lo, float hi) { return pg8::cvt_pk_bf16(lo, hi); }
__device__ __forceinline__ float bf2f(unsigned short b) { return __uint_as_float((unsigned)b << 16); }
__device__ __forceinline__ float wave_sum(float v) {
#pragma unroll
    for (int o = 1; o < 64; o <<= 1) v += __shfl_xor(v, o);
    return v;
}

#define XB_TMO      128
#define XB_XCNT(j)  (256  + 64 * (j))
#define XB_XSUB(j)  (1280 + 64 * (j))
#define XB_XGEN(j)  (2304 + 64 * (j))
#define XB_TOP      3328
#define XB_TOPGEN   3392
#define XCD_BAR_WORDS 3456
#define XB_SPIN_CAP (1u << 18)

__device__ __forceinline__ unsigned xb_ld(unsigned* p)              { return __hip_atomic_load(p, __ATOMIC_RELAXED, __HIP_MEMORY_SCOPE_AGENT); }
__device__ __forceinline__ unsigned xb_add(unsigned* p, unsigned v) { return __hip_atomic_fetch_add(p, v, __ATOMIC_RELAXED, __HIP_MEMORY_SCOPE_AGENT); }
__device__ __forceinline__ unsigned xb_xcc_id() { return (unsigned)__builtin_amdgcn_s_getreg((3 << 11) | 20) & 0xFu; }
#define XB_SPIN(cond, bar) do { unsigned _sp = 0; while (cond) { __builtin_amdgcn_s_sleep(1); \
    if ((++_sp & 255u) == 0u) { if (xb_ld(&(bar)[XB_TMO])) break; if (_sp > XB_SPIN_CAP) { atomicAdd(&(bar)[XB_TMO], 1u); break; } } } } while (0)

struct XcdBarrier {
    unsigned* bar; unsigned x;
    volatile LAS unsigned* st;
};

__device__ __forceinline__ XcdBarrier xcd_barrier_post(unsigned* bar, volatile LAS unsigned* st) {
    XcdBarrier b; b.bar = bar; b.x = xb_xcc_id(); b.st = st;
    if (threadIdx.x == 0) (void)xb_add(&bar[XB_XCNT(b.x)], 1u);
    return b;
}
__device__ __forceinline__ void xcd_barrier_complete(unsigned* bar, unsigned x, unsigned& nloc, unsigned& nx) {
    const unsigned G = gridDim.x * gridDim.y * gridDim.z;
    unsigned sum, cnt, mine, sp = 0u;
    for (;;) {
        sum = 0u; cnt = 0u; mine = 0u;
#pragma unroll
        for (unsigned j = 0; j < 16; ++j) { const unsigned c = xb_ld(&bar[XB_XCNT(j)]); sum += c; cnt += (c > 0u) ? 1u : 0u; mine = (j == x) ? c : mine; }
        if (sum == G) break;
        __builtin_amdgcn_s_sleep(1);
        if ((++sp & 255u) == 0u) { if (xb_ld(&bar[XB_TMO])) break; if (sp > XB_SPIN_CAP) { atomicAdd(&bar[XB_TMO], 1u); break; } }
    }
    nloc = mine > 0u ? mine : 1u; nx = cnt > 0u ? cnt : 1u;
}

__device__ __forceinline__ void xcd_barrier(const XcdBarrier& b) {
    asm volatile("s_waitcnt vmcnt(0)" ::: "memory");
    __syncthreads();
    if (threadIdx.x == 0) {
        unsigned* bar = b.bar;
        __builtin_amdgcn_s_waitcnt(0);
        unsigned nloc = b.st[0], nx = b.st[1];
        if (nloc == 0u) { xcd_barrier_complete(bar, b.x, nloc, nx); b.st[0] = nloc; b.st[1] = nx; }
        const unsigned old = xb_add(&bar[XB_XSUB(b.x)], 1u);
        const unsigned gen = old / nloc;
        if (old + 1u == (gen + 1u) * nloc) {
            __builtin_amdgcn_fence(__ATOMIC_RELEASE, "agent");
            asm volatile("s_waitcnt vmcnt(0)" ::: "memory");
            const unsigned og = xb_add(&bar[XB_TOP], 1u);
            const unsigned tg = og / nx;
            if (og + 1u == (tg + 1u) * nx) xb_add(&bar[XB_TOPGEN], 1u);
            else XB_SPIN(xb_ld(&bar[XB_TOPGEN]) == tg, bar);
            __builtin_amdgcn_fence(__ATOMIC_ACQUIRE, "agent");
            xb_add(&bar[XB_XGEN(b.x)], 1u);
            asm volatile("s_waitcnt vmcnt(0)" ::: "memory");
        } else {
            XB_SPIN(xb_ld(&bar[XB_XGEN(b.x)]) == gen, bar);
            __builtin_amdgcn_fence(__ATOMIC_ACQUIRE, "agent");
            asm volatile("s_waitcnt vmcnt(0)" ::: "memory");
        }
    }
    __syncthreads();
}

__device__ __forceinline__ void tr_item(const float* W, int K, int N, bf16* WT, int k0, int n0, int drow0, const float* gain, LAS float* scr, int lane) {
    const int lr = lane >> 4, lc = 4 * (lane & 15);
    f32x4 wv[16];
#pragma unroll
    for (int i = 0; i < 16; ++i) wv[i] = *(const f32x4*)(W + (size_t)(k0 + 4 * i + lr) * N + n0 + lc);
#pragma unroll
    for (int i = 0; i < 16; ++i) { LAS float* d = scr + (4 * i + lr) * 65 + lc; d[0] = wv[i][0]; d[1] = wv[i][1]; d[2] = wv[i][2]; d[3] = wv[i][3]; }
    LDS_WAIT();
    const int c = lane & 7;
    f32x4 g0 = {1.f, 1.f, 1.f, 1.f}, g1 = {1.f, 1.f, 1.f, 1.f};
    if (gain) { g0 = *(const f32x4*)(gain + k0 + 8 * c); g1 = *(const f32x4*)(gain + k0 + 8 * c + 4); }
#pragma unroll
    for (int j = 0; j < 8; ++j) {
        const int n = (lane >> 3) + 8 * j; const LAS float* s = scr + (8 * c) * 65 + n;
        v4u o; o.x = pk2(s[0 * 65] * g0[0], s[1 * 65] * g0[1]); o.y = pk2(s[2 * 65] * g0[2], s[3 * 65] * g0[3]);
        o.z = pk2(s[4 * 65] * g1[0], s[5 * 65] * g1[1]); o.w = pk2(s[6 * 65] * g1[2], s[7 * 65] * g1[3]);
        *(v4u*)(WT + (size_t)(drow0 + n) * K + k0 + 8 * c) = o;
    }
    LDS_WAIT();
}
__device__ __forceinline__ void tr_mat(const float* W, int K, int N, bf16* WT, int item, const float* gain, int mode  , LAS float* scr, int lane) {
    const int nblk = N >> 6; const int kb = item / nblk, nb = item - kb * nblk; const int n0 = nb * 64;
    int drow0 = n0;
    if (mode) drow0 = (n0 >> 7) * 256 + (n0 & 127) + (mode == 2 ? 128 : 0);
    tr_item(W, K, N, WT, kb * 64, n0, drow0, gain, scr, lane);
}

__device__ __forceinline__ int mat_items(int id) { return id < 2 ? 32 * 64 : id < 4 ? 32 * 32 : id < 16 ? 32 * 88 : id == 16 ? 32 * 8 : 32 * 32; }
__device__ __forceinline__ void convert_item(int id, int r, kin_t in, unsigned char* ws, LAS float* scr, int lane) {
    const float* mixn = in[1]; const float* ffnn = in[2];
    if (id < 2) tr_mat(in[3] + (size_t)id * DM * 4096, DM, 4096, (bf16*)(ws + WS_AIN + (size_t)id * 16 * MiB), r, mixn + id * DM, 0, scr, lane);
    else if (id < 4) tr_mat(in[7] + (size_t)(id - 2) * DM * DM, DM, DM, (bf16*)(ws + WS_AOUT + (size_t)(id - 2) * 8 * MiB), r, nullptr, 0, scr, lane);
    else if (id < 8) tr_mat(in[17] + (size_t)(id - 4) * DM * DFF, DM, DFF, (bf16*)(ws + WS_FUP + (size_t)(id - 4) * 44 * MiB), r, ffnn + (id - 4) * DM, 1, scr, lane);
    else if (id < 12) tr_mat(in[18] + (size_t)(id - 8) * DM * DFF, DM, DFF, (bf16*)(ws + WS_FUP + (size_t)(id - 8) * 44 * MiB), r, ffnn + (id - 8) * DM, 2, scr, lane);
    else if (id < 16) tr_mat(in[19] + (size_t)(id - 12) * DFF * DM, DFF, DM, (bf16*)(ws + WS_FDN + (size_t)(id - 12) * 22 * MiB), r, nullptr, 0, scr, lane);
    else if (id == 16) tr_mat(in[9], DM, 512, (bf16*)(ws + WS_Q0) + (size_t)2048 * DM, r, in[8], 0, scr, lane);
    else if (id < 19) tr_mat(in[11] + (size_t)(id - 17) * DM * DM, DM, DM, (bf16*)(ws + (id == 18 ? WS_Q1 : WS_Q0)), r, mixn + (2 + id - 17) * DM, 0, scr, lane);
    else tr_mat(in[14] + (size_t)(id - 19) * DM * DM, DM, DM, (bf16*)(ws + WS_WO + (size_t)(id - 19) * 8 * MiB), r, nullptr, 0, scr, lane);
}
__device__ __forceinline__ void convert_set(LAS unsigned char* lds, kin_t in, unsigned char* ws, unsigned long long set, int widx, int nworkers) {
    const int tid = opaque_tid(), lane = tid & 63, wave = __builtin_amdgcn_readfirstlane(tid >> 6);
    LAS float* scr = (LAS float*)(lds + wave * 16640);
    int base = 0;
    for (; (set & 31ull) != 31ull; set >>= 5) {
        const int id = (int)(set & 31ull), n = mat_items(id);
        int start = (widx - base) % nworkers; if (start < 0) start += nworkers;
        for (int r = start; r < n; r += nworkers) convert_item(id, r, in, ws, scr, lane);
        base += n;
    }
}
#define MSET1(a) ((unsigned long long)(a) | (31ull << 5))
#define MSET3(a, b, c) ((unsigned long long)(a) | ((unsigned long long)(b) << 5) | ((unsigned long long)(c) << 10) | (31ull << 15))
#define MSET4(a, b, c, d) ((unsigned long long)(a) | ((unsigned long long)(b) << 5) | ((unsigned long long)(c) << 10) | ((unsigned long long)(d) << 15) | (31ull << 20))
#define MSET7(a, b, c, d, e, f, g) ((unsigned long long)(a) | ((unsigned long long)(b) << 5) | ((unsigned long long)(c) << 10) | ((unsigned long long)(d) << 15) | ((unsigned long long)(e) << 20) | ((unsigned long long)(f) << 25) | ((unsigned long long)(g) << 30) | (31ull << 35))
#if MK_LAZY
#define MSET5(a, b, c, d, e) ((unsigned long long)(a) | ((unsigned long long)(b) << 5) | ((unsigned long long)(c) << 10) | ((unsigned long long)(d) << 15) | ((unsigned long long)(e) << 20) | (31ull << 25))
constexpr unsigned long long SET_PRO = MSET4(0, 2, 4, 8);
constexpr unsigned long long SET_PH4 = MSET5(12, 1, 3, 9, 5), SET_PH9 = MSET4(13, 17, 16, 19), SET_PH11 = MSET3(6, 10, 7), SET_PH14 = MSET4(14, 18, 20, 11), SET_PH19 = MSET1(15);
#endif
__device__ __forceinline__ void tail_convert(LAS unsigned char* lds, kin_t in, unsigned char* ws, unsigned long long set, int nunits, int blk, int nblk) {
    const int nfull = nunits % nblk;
    if (blk < nfull) return;
    const int wave = __builtin_amdgcn_readfirstlane(threadIdx.x >> 6);
    convert_set(lds, in, ws, set, (blk - nfull) * NWAVES + wave, (nblk - nfull) * NWAVES);
}

__device__ __forceinline__ void prologue_phase(LAS unsigned char* lds, kin_t in, float* H, unsigned char* ws, int blk, int nblk) {
    const int tid = opaque_tid(), lane = tid & 63, wave = __builtin_amdgcn_readfirstlane(tid >> 6);
    const int gw = blk * NWAVES + wave, NGW = nblk * NWAVES;
#if MK_LAZY
    convert_set(lds, in, ws, SET_PRO, gw, NGW);
#else
    for (int id = 0; id < 21; ++id) convert_set(lds, in, ws, MSET1(id), gw, NGW);
#endif
    const float* x = in[0]; bf16* HB = (bf16*)(ws + WS_HB); float* hstats = (float*)(ws + WS_HSTAT);
    for (int m = gw; m < M; m += NGW) {
        const f32x4* xr = (const f32x4*)(x + (size_t)m * DM) + lane;
        v2u* hb = (v2u*)(HB + (size_t)m * DM) + lane;
        f32x4 v[8]; float s = 0.f;
#pragma unroll
        for (int j = 0; j < 8; ++j) { v[j] = xr[64 * j]; s += (v[j][0] * v[j][0] + v[j][1] * v[j][1]) + (v[j][2] * v[j][2] + v[j][3] * v[j][3]); }
        const float tot = wave_sum(s);
#pragma unroll
        for (int j = 0; j < 8; ++j) { v2u o; o.x = pk2(v[j][0], v[j][1]); o.y = pk2(v[j][2], v[j][3]); hb[64 * j] = o;
            if (MK_RESID == 3) { v2u l; l.x = pkh16(v[j][0], v[j][1]); l.y = pkh16(v[j][2], v[j][3]); ((v2u*)((bf16*)(ws + WS_LO) + (size_t)m * DM))[lane + 64 * j] = l; }
            if (MK_RESID == 2) { v2u l; l.x = pk2(v[j][0] - unpk_lo(o.x), v[j][1] - unpk_hi(o.x)); l.y = pk2(v[j][2] - unpk_lo(o.y), v[j][3] - unpk_hi(o.y)); ((v2u*)((bf16*)(ws + WS_LO) + (size_t)m * DM))[lane + 64 * j] = l; } }
        if (lane < 32) hstats[(size_t)m * 32 + lane] = (lane == 0) ? tot : 0.f;
    }
}

__device__ __forceinline__ void final_phase(float* H, const bf16* HB, const bf16* LO, const float* hstats, const float* fn, int blk, int nblk) {
    const int tid = opaque_tid(), lane = tid & 63, wave = tid >> 6;
    const int gw = blk * NWAVES + wave, NGW = nblk * NWAVES;
    if (MK_RESID == 0) {
        f32x4 g[8];
#pragma unroll
        for (int j = 0; j < 8; ++j) g[j] = ((const f32x4*)fn)[lane + 64 * j];
        for (int m = gw; m < M; m += NGW) {
            const float p = (lane < 32) ? hstats[(size_t)m * 32 + lane] : 0.f;
            const float rstd = rsqrtf(wave_sum(p) * (1.0f / 2048.0f) + 1e-5f);
            f32x4* hr = (f32x4*)(H + (size_t)m * DM) + lane;
#pragma unroll
            for (int j = 0; j < 8; ++j) { f32x4 v = hr[64 * j]; v = v * rstd * g[j]; hr[64 * j] = v; }
        }
    } else {
        f32x4 g[4][2];
#pragma unroll
        for (int j = 0; j < 4; ++j) { g[j][0] = ((const f32x4*)fn)[2 * (lane + 64 * j)]; g[j][1] = ((const f32x4*)fn)[2 * (lane + 64 * j) + 1]; }
        for (int m = gw; m < M; m += NGW) {
            v4u hb[4], lo[4];
#pragma unroll
            for (int j = 0; j < 4; ++j) { hb[j] = ((const v4u*)((MK_RESID == 3 ? LO : HB) + (size_t)m * DM))[lane + 64 * j]; if (MK_RESID == 2) lo[j] = ((const v4u*)(LO + (size_t)m * DM))[lane + 64 * j]; }
            const float p = (lane < 32) ? hstats[(size_t)m * 32 + lane] : 0.f;
            const float rstd = rsqrtf(wave_sum(p) * (1.0f / 2048.0f) + 1e-5f);
            f32x4* orow = (f32x4*)(H + (size_t)m * DM);
#pragma unroll
            for (int j = 0; j < 4; ++j) {
                f32x4 a, b; if (MK_RESID == 3) pg8::h8_to_f32(hb[j], a, b); else pg8::bf8_to_f32(hb[j], a, b);
                if (MK_RESID == 2) { f32x4 c, d; pg8::bf8_to_f32(lo[j], c, d); a = a + c; b = b + d; }
                orow[2 * (lane + 64 * j)] = a * rstd * g[j][0]; orow[2 * (lane + 64 * j) + 1] = b * rstd * g[j][1];
            }
        }
    }
}

constexpr int G_RV = 0, G_WC = 1024, G_WCP = 272, G_VT = 36864, G_VTP = 528;
__device__ __forceinline__ void gate_phase(LAS unsigned char* lds, const bf16* U, const bf16* V, bf16* G, const float* vstats, const float* Ws, const float* bs, const float* gnorm, int blk, int nblk) {
    const int tid = opaque_tid(), lane = tid & 63, wid = __builtin_amdgcn_readfirstlane(tid >> 6), l15 = lane & 15, fq = lane >> 4;
    LAS float* RV = (LAS float*)(lds + G_RV);
    for (int unit = blk; unit < 512; unit += nblk) {
        const int chunk = unit >> 3, g = unit & 7, R0 = chunk * 128;
        const int srow = tid >> 2, sq = tid & 3;
        const f32x4* sp = (const f32x4*)(vstats + (size_t)(R0 + srow) * 32 + sq * 8);
        const f32x4 sa = sp[0], sb = sp[1];
        v4u val[8]; f32x4 wsv[8]; v2u uu[8][2]; f32x4 gn[2]; float bb[8];
#pragma unroll
        for (int i = 0; i < 8; ++i) { const int idx = i * NTHREADS + tid, s_ = idx >> 5, dc = (idx & 31) * 8; val[i] = *(const v4u*)(V + (size_t)(R0 + s_) * DM + g * 256 + dc); }
#pragma unroll
        for (int i = 0; i < 8; ++i) { const int idx = i * NTHREADS + tid, t = idx >> 5, s4 = (idx & 31) * 4; wsv[i] = *(const f32x4*)(Ws + (size_t)(g * 128 + t) * 128 + s4); }
#pragma unroll
        for (int nt = 0; nt < 2; ++nt) {
            const int col = g * 256 + 32 * wid + 16 * nt + 4 * fq;
            gn[nt] = *(const f32x4*)(gnorm + col);
#pragma unroll
            for (int mt = 0; mt < 8; ++mt) uu[mt][nt] = *(const v2u*)(U + (size_t)(R0 + 16 * mt + l15) * DM + col);
        }
#pragma unroll
        for (int mt = 0; mt < 8; ++mt) bb[mt] = bs[g * 128 + 16 * mt + l15];
        {
            float s_ = ((sa[0] + sa[1]) + (sa[2] + sa[3])) + ((sb[0] + sb[1]) + (sb[2] + sb[3]));
            s_ += __shfl_xor(s_, 1); s_ += __shfl_xor(s_, 2);
            if (sq == 0) RV[srow] = rsqrtf(s_ * (1.0f / 2048.0f) + 1e-5f);
        }
#pragma unroll
        for (int i = 0; i < 8; ++i) { const int idx = i * NTHREADS + tid, s_ = idx >> 5, dc = (idx & 31) * 8; *(LAS v4u*)(lds + G_VT + s_ * G_VTP + dc * 2) = val[i]; }
        __syncthreads();
#pragma unroll
        for (int i = 0; i < 8; ++i) {
            const int idx = i * NTHREADS + tid, t = idx >> 5, s4 = (idx & 31) * 4;
            f32x4 w = wsv[i];
            const f32x4 r = *(const LAS f32x4*)(RV + s4);
#pragma unroll
            for (int e = 0; e < 4; ++e) w[e] = (s4 + e <= t) ? w[e] * r[e] : 0.f;
            v2u o; o.x = pk2(w[0], w[1]); o.y = pk2(w[2], w[3]);
            *(LAS v2u*)(lds + G_WC + t * G_WCP + s4 * 2) = o;
        }
        __syncthreads();
        f32x4 acc[8][2];
#pragma unroll
        for (int mt = 0; mt < 8; ++mt) { acc[mt][0] = (f32x4){0.f, 0.f, 0.f, 0.f}; acc[mt][1] = (f32x4){0.f, 0.f, 0.f, 0.f}; }
#pragma unroll
        for (int ks = 0; ks < 4; ++ks) {
            bf16x8 vf[2];
#pragma unroll
            for (int nt = 0; nt < 2; ++nt)
#pragma unroll
                for (int j = 0; j < 8; ++j)
                    vf[nt][j] = (short)*(const LAS unsigned short*)(lds + G_VT + (32 * ks + 8 * fq + j) * G_VTP + (32 * wid + 16 * nt + l15) * 2);
#pragma unroll
            for (int mt = 0; mt < 8; ++mt) {
                if (2 * ks < mt + 1) {
                    const bf16x8 wf = *(const LAS bf16x8*)(lds + G_WC + (16 * mt + l15) * G_WCP + (32 * ks + 8 * fq) * 2);
                    acc[mt][0] = mfma16(vf[0], wf, acc[mt][0], 0, 0, 0);
                    acc[mt][1] = mfma16(vf[1], wf, acc[mt][1], 0, 0, 0);
                }
            }
        }
#pragma unroll
        for (int nt = 0; nt < 2; ++nt) {
            const int col = g * 256 + 32 * wid + 16 * nt + 4 * fq;
#pragma unroll
            for (int mt = 0; mt < 8; ++mt) {
                const int t = 16 * mt + l15; const float b = bb[mt];
                const v2u u2 = uu[mt][nt];
                const float u0 = unpk_lo(u2.x), u1 = unpk_hi(u2.x), u2f = unpk_lo(u2.y), u3 = unpk_hi(u2.y);
                const f32x4 a = acc[mt][nt];
                v2u o; o.x = pk2(u0 * (gn[nt][0] * a[0] + b), u1 * (gn[nt][1] * a[1] + b)); o.y = pk2(u2f * (gn[nt][2] * a[2] + b), u3 * (gn[nt][3] * a[3] + b));
                *(v2u*)(G + (size_t)(R0 + t) * DM + col) = o;
            }
        }
        __syncthreads();
    }
}

constexpr int A_KS = 0, A_KSP = 144, A_VT = 36864, A_VTP = 528, A_LUT = 70656;
__device__ __forceinline__ void attn_phase(LAS unsigned char* lds, const bf16* Q, const bf16* KV, bf16* O, const float* sinks, const float* rel_bias, int blk, int nblk) {
    const int tid = opaque_tid(), lane = tid & 63, wid = __builtin_amdgcn_readfirstlane(tid >> 6), l15 = lane & 15, fq = lane >> 4;
    LAS float* LUT = (LAS float*)(lds + A_LUT);
    constexpr float LOG2E = 1.4426950408889634f;
    for (int unit = blk; unit < 256; unit += nblk) {
        const int hk = unit & 3, c = (unit >> 2) & 15, b = unit >> 6;
        const int rowq0 = b * SEQ + c * 128, rowk0 = rowq0 - 128;
        v4u kva[4], vva[4];
#pragma unroll
        for (int i = 0; i < 4; ++i) {
            const int idx = i * NTHREADS + tid, kk = idx >> 3, c8 = idx & 7;
            const bool ok = (c > 0) || (kk >= 128);
            kva[i] = (v4u){0u, 0u, 0u, 0u}; vva[i] = (v4u){0u, 0u, 0u, 0u};
            if (ok) { const bf16* p = KV + (size_t)(rowk0 + kk) * 512 + hk * 64 + c8 * 8; kva[i] = *(const v4u*)p; vva[i] = *(const v4u*)(p + 256); }
        }
#pragma unroll
        for (int i = 0; i < 4; ++i) {
            const int idx = i * NTHREADS + tid, kk = idx >> 3, c8 = idx & 7;
            const v4u kv = kva[i], vv = vva[i];
            *(LAS v4u*)(lds + A_KS + kk * A_KSP + c8 * 16) = kv;
            const int kp = (kk & ~31) + ((kk >> 2) & 3) * 8 + ((kk >> 4) & 1) * 4 + (kk & 3);
            LAS unsigned short* vt = (LAS unsigned short*)(lds + A_VT + (c8 * 8) * A_VTP + kp * 2);
            vt[0 * (A_VTP / 2)] = (unsigned short)(vv.x & 0xffffu); vt[1 * (A_VTP / 2)] = (unsigned short)(vv.x >> 16);
            vt[2 * (A_VTP / 2)] = (unsigned short)(vv.y & 0xffffu); vt[3 * (A_VTP / 2)] = (unsigned short)(vv.y >> 16);
            vt[4 * (A_VTP / 2)] = (unsigned short)(vv.z & 0xffffu); vt[5 * (A_VTP / 2)] = (unsigned short)(vv.z >> 16);
            vt[6 * (A_VTP / 2)] = (unsigned short)(vv.w & 0xffffu); vt[7 * (A_VTP / 2)] = (unsigned short)(vv.w >> 16);
        }
#pragma unroll
        for (int i = 0; i < 3; ++i) {
            const int idx = i * NTHREADS + tid, hh = idx / 192, dist = idx - hh * 192 - 32;
            float val = -1e30f;
            if (dist >= 0 && dist < 128) {
                int bucket = dist;
                if (dist >= 16) { bucket = 16 + (int)(__log2f((float)dist * 0.0625f) * (16.0f / 3.0f)); bucket = bucket > 31 ? 31 : bucket; }
                val = rel_bias[bucket * NH + hk * 8 + hh] * LOG2E;
            }
            LUT[idx] = val;
        }
        __syncthreads();
        const int h = hk * 8 + wid; const float sink = sinks[h] * LOG2E;
        const LAS float* lutb = LUT + wid * 192 + 32 + l15 + 128 - 4 * fq;
        const bf16* qbase = Q + (size_t)(rowq0 + l15) * DM + h * 64 + 8 * fq;
        bf16x8 qall[8][2];
#pragma unroll
        for (int t = 0; t < 8; ++t) { qall[t][0] = *(const bf16x8*)(qbase + (size_t)(16 * t) * DM); qall[t][1] = *(const bf16x8*)(qbase + (size_t)(16 * t) * DM + 32); }
#pragma unroll
        for (int qp = 0; qp < 4; ++qp) {
            const int kt0 = 2 * qp;
            bf16x8 qf[2][2];
#pragma unroll
            for (int t = 0; t < 2; ++t) { qf[t][0] = qall[2 * qp + t][0]; qf[t][1] = qall[2 * qp + t][1]; }
            f32x4 acc[2][10];
            const LAS unsigned char* kb = lds + A_KS + (16 * kt0 + l15) * A_KSP + 16 * fq;
#pragma unroll
            for (int r = 0; r < 10; ++r) {
                const LAS unsigned char* kp = kb + r * 16 * A_KSP;
                const bf16x8 k0 = *(const LAS bf16x8*)kp, k1 = *(const LAS bf16x8*)(kp + 64);
#pragma unroll
                for (int t = 0; t < 2; ++t) {
                    f32x4 z = {0.f, 0.f, 0.f, 0.f};
                    z = mfma16(k0, qf[t][0], z, 0, 0, 0);
                    acc[t][r] = mfma16(k1, qf[t][1], z, 0, 0, 0);
                }
            }
            float inv[2];
#pragma unroll
            for (int t = 0; t < 2; ++t) {
                float mx = -1e30f;
                float lb[10][4];
#pragma unroll
                for (int r = 0; r < 10; ++r)
#pragma unroll
                    for (int j = 0; j < 4; ++j) lb[r][j] = lutb[16 * (t - r) - j];
#pragma unroll
                for (int r = 0; r < 10; ++r) {
                    const float pen = ((c == 0) && (kt0 + r < 8)) ? -1e30f : 0.f;
#pragma unroll
                    for (int j = 0; j < 4; ++j) {
                        const float sc = acc[t][r][j] + (lb[r][j] + pen);
                        acc[t][r][j] = sc; mx = fmaxf(mx, sc);
                    }
                }
                mx = fmaxf(mx, __shfl_xor(mx, 16)); mx = fmaxf(mx, __shfl_xor(mx, 32)); mx = fmaxf(mx, sink);
                float sum = 0.f;
#pragma unroll
                for (int r = 0; r < 10; ++r)
#pragma unroll
                    for (int j = 0; j < 4; ++j) { const float pe = __builtin_amdgcn_exp2f(acc[t][r][j] - mx); acc[t][r][j] = pe; sum += pe; }
                sum += __shfl_xor(sum, 16); sum += __shfl_xor(sum, 32);
                sum += __builtin_amdgcn_exp2f(sink - mx);
                inv[t] = 1.0f / sum;
            }
            f32x4 o[2][4];
#pragma unroll
            for (int t = 0; t < 2; ++t)
#pragma unroll
                for (int dt = 0; dt < 4; ++dt) o[t][dt] = (f32x4){0.f, 0.f, 0.f, 0.f};
            const LAS unsigned char* vb = lds + A_VT + l15 * A_VTP + (32 * qp + 8 * fq) * 2;
#pragma unroll
            for (int cs = 0; cs < 5; ++cs) {
                bf16x8 pf[2];
#pragma unroll
                for (int t = 0; t < 2; ++t) {
                    v4u pw; pw.x = pk2(acc[t][2 * cs][0], acc[t][2 * cs][1]); pw.y = pk2(acc[t][2 * cs][2], acc[t][2 * cs][3]); pw.z = pk2(acc[t][2 * cs + 1][0], acc[t][2 * cs + 1][1]); pw.w = pk2(acc[t][2 * cs + 1][2], acc[t][2 * cs + 1][3]);
                    pf[t] = __builtin_bit_cast(bf16x8, pw);
                }
#pragma unroll
                for (int dt = 0; dt < 4; ++dt) {
                    const bf16x8 vf = *(const LAS bf16x8*)(vb + (16 * dt) * A_VTP + cs * 64);
                    o[0][dt] = mfma16(vf, pf[0], o[0][dt], 0, 0, 0);
                    o[1][dt] = mfma16(vf, pf[1], o[1][dt], 0, 0, 0);
                }
            }
#pragma unroll
            for (int t = 0; t < 2; ++t) {
                bf16* op = O + (size_t)(rowq0 + 16 * (2 * qp + t) + l15) * DM + h * 64 + 4 * fq;
#pragma unroll
                for (int dt = 0; dt < 4; ++dt) { v2u w; w.x = pk2(o[t][dt][0] * inv[t], o[t][dt][1] * inv[t]); w.y = pk2(o[t][dt][2] * inv[t], o[t][dt][3] * inv[t]); *(v2u*)(op + 16 * dt) = w; }
            }
        }
        __syncthreads();
    }
}

struct Args { const float* in[21]; float* out; unsigned char* ws; int ph_lo, ph_hi; };
__global__ void __launch_bounds__(NTHREADS, 2) mk_fwd(Args a_unused) {
    extern __shared__ __attribute__((aligned(16))) unsigned char lds_raw[];
    LAS unsigned char* lds = (LAS unsigned char*)lds_raw;
    const int blk = blockIdx.x, nblk = gridDim.x;
    const KAS Args* ap = (const KAS Args*)__builtin_amdgcn_kernarg_segment_ptr();
    const int ph_hi = ap->ph_hi;
#if MK_COOP
    volatile LAS unsigned* MISC = (volatile LAS unsigned*)(lds + MISC_OFF);
    if (threadIdx.x < 2) MISC[threadIdx.x] = 0u;
    __syncthreads();
    XcdBarrier bar = xcd_barrier_post((unsigned*)ap->ws, MISC);
#endif
    for (int ph = ap->ph_lo; ph < ph_hi; ++ph) {
        const KAS Args* p = ap; asm volatile("" : "+s"(p));
        unsigned char* ws = p->ws;
        float* H = p->out; bf16* HB = (bf16*)(ws + WS_HB);
        float* hstats = (float*)(ws + WS_HSTAT); float* vstats = (float*)(ws + WS_VSTAT);
        bf16* B1 = (bf16*)(ws + WS_B1); bf16* B2 = (bf16*)(ws + WS_B2); bf16* B3 = (bf16*)(ws + WS_B3);
        bf16* ACT = (bf16*)(ws + WS_ACT); bf16* KVB = (bf16*)(ws + WS_KV);
        float* xbuf = (float*)(ws + WS_XB); unsigned* sflags = (unsigned*)(ws + CTL_FLAGS);
        const bool split_ok = MK_SPLIT && (nblk == 256);
        int nrep = 1;
#ifdef MK_PROBE
        { const int sub_ = (ph - 1) % 5; const bool mid = ph > 0 && ph < N_PHASES - 1;
          if ((MK_PROBE & 1) && ph == 0) nrep = 2;
          if ((MK_PROBE & 2) && mid && sub_ == 1) nrep = 2;
          if ((MK_PROBE & 4) && mid && sub_ == 3) nrep = 2;
          if ((MK_PROBE & 8) && mid && sub_ == 0) nrep = 2; }
#endif
        for (int rep = 0; rep < nrep; ++rep) {
        if (ph == 0) prologue_phase(lds, p->in, H, ws, blk, nblk);
        else if (ph == N_PHASES - 1) final_phase(H, HB, (const bf16*)(ws + WS_LO), hstats, p->in[20], blk, nblk);
        else {
            const int L = (ph - 1) / 5, sub = (ph - 1) % 5, i = L - 2;
            if (sub == 0) {
                if (L < 2) {
                    pg8::Gemm g{HB, (const bf16*)(ws + WS_AIN + (size_t)L * 16 * MiB), M, 4096, DM, DM / 64}; pg8::StaticOrder S; S.init(M, 4096, nblk, blk);
                    PG8_LAS float* tab = (PG8_LAS float*)(lds + TAB_OFF); pg8::build_ms_table(tab, hstats, S);
                    pg8::EpiGeluUV E{B1, B2, hstats, vstats, tab};
                    pg8::gemm_phase<pg8::EpiGeluUV, pg8::StaticOrder, true, true>(lds, g, S, E);
                } else {
                    const bool split = split_ok && (i == 0);
                    const int N = (i == 0 && !split) ? 2560 : 2048;
                    pg8::Gemm g{HB, (const bf16*)(ws + (i ? WS_Q1 : WS_Q0)), M, N, DM, DM / 64}; pg8::StaticOrder S; S.init(M, N, nblk, blk);
#if MK_LAZY
                    if (i == 0) { tail_convert(lds, p->in, ws, SET_PH11, split ? 256 : 320, blk, nblk); __syncthreads(); }
#endif
                    PG8_LAS float* tab = split ? (PG8_LAS float*)nullptr : (PG8_LAS float*)(lds + TAB_OFF); if (!split) pg8::build_ms_table(tab, hstats, S);
                    pg8::EpiQKV E{B1, KVB, hstats, p->in[12] + i * DM, p->in[10], 0.125f * 1.4426950408889634f, tab};
                    pg8::Unit su; pg8::SplitOrder S2{S, 0, 4, 64, 1, blk}; bool has_split = false;
                    if (split) {
                        has_split = S2.next(0, su);
                        pg8::Gemm g2{HB, (const bf16*)(ws + WS_Q0), M, 2560, DM, 8};
                        pg8::EpiStore E2{xbuf, sflags + 4 * 128, 4};
                        pg8::gemm_phase<pg8::EpiStore, pg8::SplitOrder, false, true>(lds, g2, S2, E2);
                    }
                    pg8::gemm_phase<pg8::EpiQKV, pg8::StaticOrder, true, true>(lds, g, S, E);
                    if (has_split) pg8::split_fixup(E, xbuf, sflags + 4 * 128, 4, su);
                }
            } else if (sub == 1) {
                if (L < 2) gate_phase(lds, B1, B2, B3, vstats, p->in[5] + (size_t)L * 8 * 128 * 128, p->in[6] + L * 8 * 128, p->in[4] + L * DM, blk, nblk);
                else attn_phase(lds, B1, KVB, B2, p->in[13] + i * NH, p->in[16], blk, nblk);
            } else if (sub == 3) {
                pg8::Gemm g{HB, (const bf16*)(ws + WS_FUP + (size_t)L * 44 * MiB), M, 2 * DFF, DM, DM / 64}; pg8::StaticOrder S; S.init(M, 2 * DFF, nblk, blk);
                if (split_ok) S.limit = 1280;
#if MK_LAZY
                tail_convert(lds, p->in, ws, L == 0 ? SET_PH4 : L == 1 ? SET_PH9 : L == 2 ? SET_PH14 : SET_PH19, split_ok ? 256 : 1408, blk, nblk);
                __syncthreads();
#endif
                PG8_LAS float* tab = split_ok ? (PG8_LAS float*)nullptr : (PG8_LAS float*)(lds + TAB_OFF); if (!split_ok) pg8::build_ms_table(tab, hstats, S);
                pg8::EpiSwiglu E{ACT, hstats, tab};
                pg8::Unit su; pg8::SplitOrder S2{S, 1280, 2, 128, 0, blk}; bool has_split = false;
                if (split_ok) {
                    has_split = S2.next(0, su);
                    pg8::Gemm g2{HB, (const bf16*)(ws + WS_FUP + (size_t)L * 44 * MiB), M, 2 * DFF, DM, 16};
                    pg8::EpiStore E2{xbuf, sflags + L * 128, 2};
                    pg8::gemm_phase<pg8::EpiStore, pg8::SplitOrder, false, true>(lds, g2, S2, E2);
                }
                pg8::gemm_phase<pg8::EpiSwiglu, pg8::StaticOrder, true, true>(lds, g, S, E);
                if (has_split) pg8::split_fixup(E, xbuf, sflags + L * 128, 2, su);
            } else {
                const bf16* A; const bf16* Bt; int K; const float* bias = nullptr;
                if (sub == 2) { K = DM; if (L < 2) { A = B3; Bt = (const bf16*)(ws + WS_AOUT + (size_t)L * 8 * MiB); } else { A = B2; Bt = (const bf16*)(ws + WS_WO + (size_t)i * 8 * MiB); bias = p->in[15] + i * DM; } }
                else { K = DFF; A = ACT; Bt = (const bf16*)(ws + WS_FDN + (size_t)L * 22 * MiB); }
                pg8::Gemm g{A, Bt, M, DM, K, K / 64}; pg8::StaticOrder S; S.init(M, DM, nblk, blk);
                pg8::EpiResid E{H, HB, hstats, bias, (ph == 3) ? p->in[0] : (MK_RESID == 0 ? (const float*)H : (const float*)nullptr), (bf16*)(ws + WS_LO)};
                pg8::gemm_phase<pg8::EpiResid, pg8::StaticOrder, true, true>(lds, g, S, E);
            }
        }
        }
        if (ph + 1 < ph_hi) {
#if MK_COOP
            if (ph_hi > 1000) cg::this_grid().sync();
            xcd_barrier(bar);
#endif
        }
    }
}

extern "C" void kernel_launch(void* const* d_in, const int* in_sizes, int n_in, void* d_out, int out_size, void* d_ws, size_t ws_size, hipStream_t stream) {
    static int grid = 0;
    if (grid == 0) {
        if (n_in != 21 || out_size != M * DM || ws_size < WS_END) { fprintf(stderr, "kernel_launch: unexpected shapes (n_in %d out %d ws %zu)\n", n_in, out_size, ws_size); grid = -1; return; }
        int dev = 0, cus = 0, per_cu = 0;
        hipGetDevice(&dev); hipDeviceGetAttribute(&cus, hipDeviceAttributeMultiprocessorCount, dev);
        hipFuncSetAttribute((const void*)mk_fwd, hipFuncAttributeMaxDynamicSharedMemorySize, LDS_BYTES);
        if (hipOccupancyMaxActiveBlocksPerMultiprocessor(&per_cu, (const void*)mk_fwd, NTHREADS, LDS_BYTES) != hipSuccess || per_cu < 1) per_cu = 1;
        (void)hipGetLastError();
        grid = cus * per_cu;
        if (grid <= 0) grid = 256;
    }
    if (grid < 0) return;
    Args a{};
    for (int i = 0; i < 21; ++i) a.in[i] = (const float*)d_in[i];
    a.out = (float*)d_out; a.ws = (unsigned char*)d_ws;
#if MK_COOP
    if (hipMemsetAsync(d_ws, 0, CTL_ZERO_BYTES, stream) != hipSuccess) { fprintf(stderr, "kernel_launch: memset failed\n"); return; }
    a.ph_lo = 0; a.ph_hi = N_PHASES;
    void* args[] = {&a};
    hipError_t e = hipLaunchCooperativeKernel((const void*)mk_fwd, dim3(grid), dim3(NTHREADS), args, LDS_BYTES, stream);
    if (e != hipSuccess) fprintf(stderr, "cooperative launch failed: %s (grid %d)\n", hipGetErrorString(e), grid);
#else
    for (int ph = 0; ph < N_PHASES; ++ph) {
        a.ph_lo = ph; a.ph_hi = ph + 1;
        hipLaunchKernelGGL(mk_fwd, dim3(grid), dim3(NTHREADS), LDS_BYTES, stream, a);
    }
#endif
}
```

```cpp
#include <hip/hip_runtime.h>
#include <hip/hip_cooperative_groups.h>
#include <cstdio>
#include <cstdint>
namespace cg = cooperative_groups;
#ifndef MK_COOP
#define MK_COOP 1
#endif
#ifndef MK_SPLIT
#define MK_SPLIT 0
#endif
#ifndef MK_LAZY
#define MK_LAZY 1
#endif
#ifndef MK_XLOCAL
#define MK_XLOCAL 1
#endif
#ifndef MK_RESID
#define MK_RESID 1
#endif
__device__ __forceinline__ int opaque_tid() { int t = threadIdx.x; asm volatile("" : "+v"(t)); return t; }
#ifndef MK_F16
#define MK_F16 0
#endif
typedef _Float16 h16x2_t __attribute__((ext_vector_type(2)));
typedef _Float16 h16x8_t __attribute__((ext_vector_type(8)));
typedef short s16x8_t __attribute__((ext_vector_type(8)));
typedef float f32x4_t __attribute__((ext_vector_type(4)));
__device__ __forceinline__ unsigned pkh16(float lo, float hi) { unsigned r; asm volatile("v_cvt_pk_f16_f32 %0, %1, %2" : "=v"(r) : "v"(lo), "v"(hi)); return r; }
__device__ __forceinline__ float unpkh_lo(unsigned w) { return (float)__builtin_bit_cast(h16x2_t, w)[0]; }
__device__ __forceinline__ float unpkh_hi(unsigned w) { return (float)__builtin_bit_cast(h16x2_t, w)[1]; }
#if MK_F16
__device__ __forceinline__ unsigned pk16(float lo, float hi) { unsigned r; asm volatile("v_cvt_pk_f16_f32 %0, %1, %2" : "=v"(r) : "v"(lo), "v"(hi)); return r; }
__device__ __forceinline__ float unpk_lo(unsigned w) { return (float)__builtin_bit_cast(h16x2_t, w)[0]; }
__device__ __forceinline__ float unpk_hi(unsigned w) { return (float)__builtin_bit_cast(h16x2_t, w)[1]; }
__device__ __forceinline__ f32x4_t mfma16(s16x8_t a, s16x8_t b, f32x4_t c, int, int, int) { return __builtin_amdgcn_mfma_f32_16x16x32_f16(__builtin_bit_cast(h16x8_t, a), __builtin_bit_cast(h16x8_t, b), c, 0, 0, 0); }
#else
__device__ __forceinline__ unsigned pk16(float lo, float hi) { unsigned r; asm volatile("v_cvt_pk_bf16_f32 %0, %1, %2" : "=v"(r) : "v"(lo), "v"(hi)); return r; }
__device__ __forceinline__ float unpk_lo(unsigned w) { return __uint_as_float(w << 16); }
__device__ __forceinline__ float unpk_hi(unsigned w) { return __uint_as_float(w & 0xffff0000u); }
__device__ __forceinline__ f32x4_t mfma16(s16x8_t a, s16x8_t b, f32x4_t c, int, int, int) { return __builtin_amdgcn_mfma_f32_16x16x32_bf16(a, b, c, 0, 0, 0); }
#endif
namespace pg8 {
#define PG8_LAS __attribute__((address_space(3)))
typedef unsigned short bf16_t;
typedef short bf16x8 __attribute__((ext_vector_type(8)));
typedef float f32x4 __attribute__((ext_vector_type(4)));
typedef unsigned u32x4 __attribute__((ext_vector_type(4)));
constexpr int BM = 256, BK = 64, HALF = 128, HTB = HALF * BK * 2  , STAGE_BYTES = 8 * HTB, NXCD = 8, WGM = 4;

__host__ __device__ __forceinline__ int lds_byte(int r, int c) { const int st = (r >> 4) * 2 + (c >> 5), rr = r & 15, cc = c & 31, ob = rr * 64 + cc * 2; return st * 1024 + (ob ^ (((ob >> 9) & 1) << 5)); }
__host__ __device__ __forceinline__ void stage_rc(int b, int& R, int& C) { const int st = b / 1024, sb = b % 1024, swz = sb ^ (((sb >> 9) & 1) << 5); R = (st >> 1) * 16 + swz / 64; C = (st & 1) * 32 + (swz % 64) / 2; }
__host__ __device__ __forceinline__ int perm32(int rho) { const int n = rho >> 4, i = rho & 15; return 8 * (i >> 2) + 4 * n + (i & 3); }

struct Unit { int pm, pn, kp, slot; };
struct Gemm { const bf16_t* A; const bf16_t* Bt; int M, N, K, nt; };

struct StaticOrder {
    int nM, nN, nwg, G, c, limit;
    __host__ __device__ void init(int M, int N, int G_, int c_) { nM = M / BM; nN = N / BM; nwg = nM * nN; G = G_; c = c_; limit = nwg; }
    __host__ __device__ void map(int L, Unit& u) const {
        int wgid = L; { const int q = nwg / NXCD, r = nwg % NXCD, xcd = wgid % NXCD, off = wgid / NXCD; wgid = (xcd < r ? xcd * (q + 1) : r * (q + 1) + (xcd - r) * q) + off; }
        const int nig = WGM * nN, gid = wgid / nig, fm = gid * WGM, gsz = (nM - fm) < WGM ? (nM - fm) : WGM;
        u.pm = fm + ((wgid % nig) % gsz); u.pn = (wgid % nig) / gsz; u.kp = 0; u.slot = 0;
    }
    __host__ __device__ bool next(int i, Unit& u) const {
        const long L = (long)i * G + c; if (L >= limit) return false;
        map((int)L, u); u.slot = i; return true;
    }
    __device__ __forceinline__ void a_ready(const Unit&) const {}
    __device__ __forceinline__ void done(const Unit&) const {}
};
struct SplitOrder {
    StaticOrder base; int L0, S, ntiles, kvmode, c;
    __device__ bool next(int i, Unit& u) const {
        if (i > 0) return false;
        const int slot = (c / (8 * S)) * 8 + (c & 7); if (slot >= ntiles) return false;
        if (kvmode) { u.pm = slot >> 1; u.pn = 8 + (slot & 1); } else base.map(L0 + slot, u);
        u.kp = (c >> 3) % S; u.slot = slot; return true;
    }
    __device__ __forceinline__ void a_ready(const Unit&) const {}
    __device__ __forceinline__ void done(const Unit&) const {}
};

__device__ __forceinline__ unsigned cvt_pk_bf16(float lo, float hi) { return pk16(lo, hi); }
typedef float f32x2 __attribute__((ext_vector_type(2)));
__device__ __forceinline__ float fast_sigmoid_mul(float x, float z) {   return x * __builtin_amdgcn_rcpf(1.0f + __builtin_amdgcn_exp2f(z * -1.4426950408889634f)); }
__device__ __forceinline__ float gelu_tanh(float x) { const float y2 = x * (1.5957691216057308f + 0.07135481627f * x * x); return fast_sigmoid_mul(x, y2); }
__device__ __forceinline__ float silu_f(float x) { return fast_sigmoid_mul(x, x); }
__device__ __forceinline__ void row_rstd(const float* stats, int row0, int fq, float (&rs)[2][4]) {
#pragma unroll
    for (int ai = 0; ai < 2; ++ai) {
        f32x4 pa[4], pb[4];
#pragma unroll
        for (int m = 0; m < 4; ++m) { const f32x4* p = (const f32x4*)(stats + (size_t)(row0 + ai * HALF + m * 16) * 32 + fq * 8); pa[m] = p[0]; pb[m] = p[1]; }
#pragma unroll
        for (int m = 0; m < 4; ++m) {
            const f32x4 a = pa[m], b = pb[m];
            float s = ((a[0] + a[1]) + (a[2] + a[3])) + ((b[0] + b[1]) + (b[2] + b[3]));
            s += __shfl_xor(s, 16); s += __shfl_xor(s, 32);
            rs[ai][m] = rsqrtf(s * (1.0f / 2048.0f) + 1e-5f);
        }
    }
}
__device__ __forceinline__ void row_rstd2(const float* stats, int row0, int fq, float (&rs)[2][4], float (&ms)[2][4]) {
#pragma unroll
    for (int ai = 0; ai < 2; ++ai) {
        f32x4 pa[4], pb[4];
#pragma unroll
        for (int m = 0; m < 4; ++m) { const f32x4* p = (const f32x4*)(stats + (size_t)(row0 + ai * HALF + m * 16) * 32 + fq * 8); pa[m] = p[0]; pb[m] = p[1]; }
#pragma unroll
        for (int m = 0; m < 4; ++m) {
            const f32x4 a = pa[m], b = pb[m];
            float s = ((a[0] + a[1]) + (a[2] + a[3])) + ((b[0] + b[1]) + (b[2] + b[3]));
            s += __shfl_xor(s, 16); s += __shfl_xor(s, 32);
            ms[ai][m] = s * (1.0f / 2048.0f) + 1e-5f; rs[ai][m] = rsqrtf(ms[ai][m]);
        }
    }
}
__device__ __forceinline__ void build_ms_table(PG8_LAS float* tab, const float* stats, const StaticOrder& S) {
    const int tid = opaque_tid(), row = tid >> 1, half = tid & 1;
    Unit u0, u; const bool any = S.next(0, u0); if (!any) return;
    f32x4 v[6][4];
#pragma unroll
    for (int i = 0; i < 6; ++i) {
        if (!S.next(i, u)) u = u0;
        const f32x4* p = (const f32x4*)(stats + (size_t)(u.pm * BM + row) * 32 + half * 16);
#pragma unroll
        for (int k = 0; k < 4; ++k) v[i][k] = p[k];
    }
#pragma unroll
    for (int i = 0; i < 6; ++i) {
        float sm = 0.f;
#pragma unroll
        for (int k = 0; k < 4; ++k) sm += (v[i][k][0] + v[i][k][1]) + (v[i][k][2] + v[i][k][3]);
        sm += __shfl_xor(sm, 1);
        if (half == 0) tab[i * BM + row] = sm * (1.0f / 2048.0f) + 1e-5f;
    }
}
__device__ __forceinline__ void tab_rstd(const PG8_LAS float* tab, const Unit& u, int wr, int fr, float (&rs)[2][4], float (&ms)[2][4]) {
#pragma unroll
    for (int ai = 0; ai < 2; ++ai)
#pragma unroll
        for (int m = 0; m < 4; ++m) { ms[ai][m] = tab[u.slot * BM + ai * HALF + wr * 64 + m * 16 + fr]; rs[ai][m] = rsqrtf(ms[ai][m]); }
}
__device__ __forceinline__ u32x4 pack8(const f32x4 v0, const f32x4 v1) { u32x4 w; w.x = cvt_pk_bf16(v0[0], v0[1]); w.y = cvt_pk_bf16(v0[2], v0[3]); w.z = cvt_pk_bf16(v1[0], v1[1]); w.w = cvt_pk_bf16(v1[2], v1[3]); return w; }
__device__ __forceinline__ float sq8(const f32x4 v0, const f32x4 v1) { return ((v0[0] * v0[0] + v0[1] * v0[1]) + (v0[2] * v0[2] + v0[3] * v0[3])) + ((v1[0] * v1[0] + v1[1] * v1[1]) + (v1[2] * v1[2] + v1[3] * v1[3])); }

struct EpiGeluUV {
    static constexpr bool PERM = true, AFTER_DRAIN = false;
    bf16_t* U; bf16_t* V; const float* hstats; float* vstats; const PG8_LAS float* tab;
    __device__ __forceinline__ void operator()(const f32x4 (&acc)[2][2][4][2], const Unit& u, int wr, int wc, int fr, int fq) const {
        const int row0 = u.pm * BM + wr * 64 + fr;
        float rs[2][4], ms_[2][4]; tab_rstd(tab, u, wr, fr, rs, ms_);
        const bool isv = u.pn >= 8; const int ct = isv ? u.pn - 8 : u.pn;
        bf16_t* base = isv ? V : U; const int col0 = ct * BM + wc * 32 + 8 * fq;
#pragma unroll
        for (int ai = 0; ai < 2; ++ai)
#pragma unroll
            for (int m = 0; m < 4; ++m) {
                const int row = row0 + ai * HALF + m * 16; const float r = rs[ai][m]; float ss = 0.f;
#pragma unroll
                for (int bj = 0; bj < 2; ++bj) {
                    f32x4 v0 = acc[ai][bj][m][0] * r, v1 = acc[ai][bj][m][1] * r;
#pragma unroll
                    for (int e = 0; e < 4; ++e) { v0[e] = gelu_tanh(v0[e]); v1[e] = gelu_tanh(v1[e]); }
                    ss += sq8(v0, v1);
                    *(u32x4*)(base + (size_t)row * 2048 + col0 + bj * HALF) = pack8(v0, v1);
                }
                if (isv) { ss += __shfl_xor(ss, 16); ss += __shfl_xor(ss, 32); if (fq == 0) vstats[(size_t)row * 32 + ct * 4 + wc] = ss; }
            }
    }
};
__device__ __forceinline__ void bf8_to_f32(const u32x4 w, f32x4& a, f32x4& b) {
    a[0] = unpk_lo(w.x); a[1] = unpk_hi(w.x); a[2] = unpk_lo(w.y); a[3] = unpk_hi(w.y);
    b[0] = unpk_lo(w.z); b[1] = unpk_hi(w.z); b[2] = unpk_lo(w.w); b[3] = unpk_hi(w.w);
}
__device__ __forceinline__ void h8_to_f32(const u32x4 w, f32x4& a, f32x4& b) {
    a[0] = unpkh_lo(w.x); a[1] = unpkh_hi(w.x); a[2] = unpkh_lo(w.y); a[3] = unpkh_hi(w.y);
    b[0] = unpkh_lo(w.z); b[1] = unpkh_hi(w.z); b[2] = unpkh_lo(w.w); b[3] = unpkh_hi(w.w);
}
struct EpiResid {
    static constexpr bool PERM = true, AFTER_DRAIN = false;
    float* H; bf16_t* HB; float* hstats; const float* bias; const float* Hin;
    bf16_t* LO;
    __device__ __forceinline__ void operator()(const f32x4 (&acc)[2][2][4][2], const Unit& u, int wr, int wc, int fr, int fq) const {
        const int row0 = u.pm * BM + wr * 64 + fr; const int col0 = u.pn * BM + wc * 32 + 8 * fq;
        f32x4 bv[2][2];
#pragma unroll
        for (int bj = 0; bj < 2; ++bj)
#pragma unroll
            for (int n = 0; n < 2; ++n) bv[bj][n] = bias ? *(const f32x4*)(bias + col0 + bj * HALF + 4 * n) : (f32x4){0.f, 0.f, 0.f, 0.f};
        if (Hin) {
            f32x4 hv[3][2][2];
#define RESID_LOAD(buf, g) do { _Pragma("unroll") for (int bj = 0; bj < 2; ++bj) { \
            const float* hp_ = Hin + (size_t)(row0 + ((g) >> 2) * HALF + ((g) & 3) * 16) * 2048 + col0 + bj * HALF; hv[buf][bj][0] = *(const f32x4*)hp_; hv[buf][bj][1] = *(const f32x4*)(hp_ + 4); } } while (0)
            RESID_LOAD(0, 0); RESID_LOAD(1, 1);
#pragma unroll
            for (int g = 0; g < 8; ++g) {
                const int ai = g >> 2, m = g & 3;
                if (g + 2 < 8) RESID_LOAD((g + 2) % 3, g + 2);
                const int row = row0 + ai * HALF + m * 16; float ss = 0.f;
#pragma unroll
                for (int bj = 0; bj < 2; ++bj) {
                    f32x4 h0 = hv[g % 3][bj][0], h1 = hv[g % 3][bj][1];
                    h0 = h0 + (acc[ai][bj][m][0] + bv[bj][0]); h1 = h1 + (acc[ai][bj][m][1] + bv[bj][1]);
                    store_h(row, col0 + bj * HALF, h0, h1);
                    ss += sq8(h0, h1);
                }
                ss += __shfl_xor(ss, 16); ss += __shfl_xor(ss, 32);
                if (fq == 0) hstats[(size_t)row * 32 + u.pn * 4 + wc] = ss;
            }
#undef RESID_LOAD
        } else {
            constexpr int NB = (MK_RESID == 2) ? 2 : 3;
            u32x4 hv[NB][2][2];
#define RESID_LOAD(buf, g) do { _Pragma("unroll") for (int bj = 0; bj < 2; ++bj) { \
            const size_t o_ = (size_t)(row0 + ((g) >> 2) * HALF + ((g) & 3) * 16) * 2048 + col0 + bj * HALF; hv[buf][bj][0] = *(const u32x4*)((MK_RESID == 3 ? LO : HB) + o_); if (MK_RESID == 2) hv[buf][bj][1] = *(const u32x4*)(LO + o_); } } while (0)
            RESID_LOAD(0, 0); if (NB == 3) RESID_LOAD(1, 1);
#pragma unroll
            for (int g = 0; g < 8; ++g) {
                const int ai = g >> 2, m = g & 3;
                if (g + NB - 1 < 8) RESID_LOAD((g + NB - 1) % NB, g + NB - 1);
                const int row = row0 + ai * HALF + m * 16; float ss = 0.f;
#pragma unroll
                for (int bj = 0; bj < 2; ++bj) {
                    f32x4 h0, h1; if (MK_RESID == 3) h8_to_f32(hv[g % NB][bj][0], h0, h1); else bf8_to_f32(hv[g % NB][bj][0], h0, h1);
                    if (MK_RESID == 2) { f32x4 l0, l1; bf8_to_f32(hv[g % NB][bj][1], l0, l1); h0 = h0 + l0; h1 = h1 + l1; }
                    h0 = h0 + (acc[ai][bj][m][0] + bv[bj][0]); h1 = h1 + (acc[ai][bj][m][1] + bv[bj][1]);
                    store_h(row, col0 + bj * HALF, h0, h1);
                    ss += sq8(h0, h1);
                }
                ss += __shfl_xor(ss, 16); ss += __shfl_xor(ss, 32);
                if (fq == 0) hstats[(size_t)row * 32 + u.pn * 4 + wc] = ss;
            }
#undef RESID_LOAD
        }
    }
    __device__ __forceinline__ void store_h(int row, int col, const f32x4 h0, const f32x4 h1) const {
        const size_t o = (size_t)row * 2048 + col;
        const u32x4 hi = pack8(h0, h1);
        *(u32x4*)(HB + o) = hi;
        if (MK_RESID == 0) { *(f32x4*)(H + o) = h0; *(f32x4*)(H + o + 4) = h1; }
        if (MK_RESID == 2) { f32x4 a, b; bf8_to_f32(hi, a, b); *(u32x4*)(LO + o) = pack8(h0 - a, h1 - b); }
        if (MK_RESID == 3) { u32x4 w; w.x = pkh16(h0[0], h0[1]); w.y = pkh16(h0[2], h0[3]); w.z = pkh16(h1[0], h1[1]); w.w = pkh16(h1[2], h1[3]); *(u32x4*)(LO + o) = w; }
    }
};
struct EpiSwiglu {
    static constexpr bool PERM = true, AFTER_DRAIN = false;
    bf16_t* ACT; const float* hstats; const PG8_LAS float* tab;
    __device__ __forceinline__ void operator()(const f32x4 (&acc)[2][2][4][2], const Unit& u, int wr, int wc, int fr, int fq) const { run(acc, u, wr, wc, fr, fq, 3, 3); }
    __device__ __forceinline__ void run(const f32x4 (&acc)[2][2][4][2], const Unit& u, int wr, int wc, int fr, int fq, int aimask, int  ) const {
        const int row0 = u.pm * BM + wr * 64 + fr; const int col0 = u.pn * HALF + wc * 32 + 8 * fq;
        float rs[2][4], ms[2][4]; if (tab) tab_rstd(tab, u, wr, fr, rs, ms); else row_rstd2(hstats, row0, fq, rs, ms);
#pragma unroll
        for (int ai = 0; ai < 2; ++ai) {
            if (!((aimask >> ai) & 1)) continue;
#pragma unroll
            for (int m = 0; m < 4; ++m) {
                const int row = row0 + ai * HALF + m * 16; const float rn = rs[ai][m] * -1.4426950408889634f, mq = ms[ai][m];
                f32x4 g0 = acc[ai][0][m][0], g1 = acc[ai][0][m][1]; const f32x4 u0 = acc[ai][1][m][0], u1 = acc[ai][1][m][1];
#pragma unroll
                for (int e = 0; e < 4; ++e) {
                    const float e0 = __builtin_amdgcn_exp2f(g0[e] * rn), e1 = __builtin_amdgcn_exp2f(g1[e] * rn);
                    g0[e] = (g0[e] * u0[e]) * __builtin_amdgcn_rcpf(__builtin_fmaf(e0, mq, mq)); g1[e] = (g1[e] * u1[e]) * __builtin_amdgcn_rcpf(__builtin_fmaf(e1, mq, mq));
                }
                *(u32x4*)(ACT + (size_t)row * 5632 + col0) = pack8(g0, g1);
            }
        }
    }
};
struct EpiQKV {
    static constexpr bool PERM = true, AFTER_DRAIN = false;
    bf16_t* Q; bf16_t* KV; const float* hstats; const float* bq; const float* bkv; float qscale; const PG8_LAS float* tab;
    __device__ __forceinline__ void operator()(const f32x4 (&acc)[2][2][4][2], const Unit& u, int wr, int wc, int fr, int fq) const { run(acc, u, wr, wc, fr, fq, 3, 3); }
    __device__ __forceinline__ void run(const f32x4 (&acc)[2][2][4][2], const Unit& u, int wr, int wc, int fr, int fq, int aimask, int bjmask) const {
        const int row0 = u.pm * BM + wr * 64 + fr;
        float rs[2][4], ms_[2][4]; if (tab) tab_rstd(tab, u, wr, fr, rs, ms_); else row_rstd(hstats, row0, fq, rs);
        const bool isq = u.pn < 8; const int ct = isq ? u.pn : u.pn - 8; const int ldc = isq ? 2048 : 512;
        bf16_t* base = isq ? Q : KV; const float* bias = isq ? bq : bkv; const float sc = isq ? qscale : 1.0f;
        const int col0 = ct * BM + wc * 32 + 8 * fq;
        f32x4 bv[2][2];
#pragma unroll
        for (int bj = 0; bj < 2; ++bj)
#pragma unroll
            for (int n = 0; n < 2; ++n) bv[bj][n] = *(const f32x4*)(bias + col0 + bj * HALF + 4 * n);
#pragma unroll
        for (int ai = 0; ai < 2; ++ai) {
            if (!((aimask >> ai) & 1)) continue;
#pragma unroll
            for (int m = 0; m < 4; ++m) {
                const int row = row0 + ai * HALF + m * 16; const float r = rs[ai][m];
#pragma unroll
                for (int bj = 0; bj < 2; ++bj) {
                    if (!((bjmask >> bj) & 1)) continue;
                    const f32x4 v0 = (acc[ai][bj][m][0] * r + bv[bj][0]) * sc, v1 = (acc[ai][bj][m][1] * r + bv[bj][1]) * sc;
                    *(u32x4*)(base + (size_t)row * ldc + col0 + bj * HALF) = pack8(v0, v1);
                }
            }
        }
    }
};

struct EpiStore {
    static constexpr bool PERM = true, AFTER_DRAIN = true;
    float* xbuf; unsigned* flags; int S;
    __device__ __forceinline__ void fused(f32x4 (&acc)[2][2][4][2], const Unit& u, int wr, int wc, int fr, int fq, PG8_LAS unsigned char* lds, int wid, int lane) const {
        typedef __attribute__((address_space(1))) unsigned gu32;
        const int tid = wid * 64 + lane;
        const f32x4* dst = (const f32x4*)xbuf + ((size_t)(u.slot * S + u.kp) * 32) * 512 + tid;
#pragma unroll
        for (int ai = 0; ai < 2; ++ai)
#pragma unroll
            for (int bj = 0; bj < 2; ++bj)
#pragma unroll
                for (int m = 0; m < 4; ++m)
#pragma unroll
                    for (int n = 0; n < 2; ++n) {
                        const f32x4 v = acc[ai][bj][m][n]; const f32x4* d = dst + (size_t)(((ai * 2 + bj) * 4 + m) * 2 + n) * 512;
                        asm volatile("global_store_dwordx4 %0, %1, off sc1" :: "v"(d), "v"(v) : "memory");
                    }
        asm volatile("s_waitcnt vmcnt(0)" ::: "memory");
        __syncthreads();
        if (tid == 0) __hip_atomic_fetch_add((gu32*)(flags + u.slot), 1u, __ATOMIC_RELAXED, __HIP_MEMORY_SCOPE_AGENT);
    }
};
template <class Inner> __device__ __forceinline__ void split_fixup(const Inner& inner, const float* xbuf, unsigned* flags, int S, const Unit& u) {
    typedef __attribute__((address_space(1))) unsigned gu32;
    const int tid = opaque_tid(), wid = tid >> 6, lane = tid & 63, wr = wid >> 2, wc = wid & 3, fr = lane & 15, fq = lane >> 4;
    if (tid == 0) {
        unsigned sp = 0;
        while (__hip_atomic_load((gu32*)(flags + u.slot), __ATOMIC_RELAXED, __HIP_MEMORY_SCOPE_AGENT) < (unsigned)S) { __builtin_amdgcn_s_sleep(2); if (++sp > (1u << 22)) break; }
        __builtin_amdgcn_fence(__ATOMIC_ACQUIRE, "agent");
        asm volatile("s_waitcnt vmcnt(0)" ::: "memory");
    }
    __syncthreads();
    const int aimask = (S == 2) ? (1 << u.kp) : (1 << (u.kp >> 1)), bjmask = (S == 2) ? 3 : (1 << (u.kp & 1));
    f32x4 acc[2][2][4][2];
#pragma unroll
    for (int ai = 0; ai < 2; ++ai)
#pragma unroll
        for (int bj = 0; bj < 2; ++bj)
#pragma unroll
            for (int m = 0; m < 4; ++m)
#pragma unroll
                for (int n = 0; n < 2; ++n) acc[ai][bj][m][n] = (f32x4){0.f, 0.f, 0.f, 0.f};
    for (int h = 0; h < S; ++h) {
        const f32x4* src = (const f32x4*)xbuf + ((size_t)(u.slot * S + h) * 32) * 512 + tid;
#pragma unroll
        for (int ai = 0; ai < 2; ++ai) {
            if (!((aimask >> ai) & 1)) continue;
#pragma unroll
            for (int bj = 0; bj < 2; ++bj) {
                if (!((bjmask >> bj) & 1)) continue;
                f32x4 t[4][2];
#pragma unroll
                for (int m = 0; m < 4; ++m)
#pragma unroll
                    for (int n = 0; n < 2; ++n) t[m][n] = src[(size_t)(((ai * 2 + bj) * 4 + m) * 2 + n) * 512];
#pragma unroll
                for (int m = 0; m < 4; ++m)
#pragma unroll
                    for (int n = 0; n < 2; ++n) acc[ai][bj][m][n] = acc[ai][bj][m][n] + t[m][n];
            }
        }
    }
    inner.run(acc, u, wr, wc, fr, fq, aimask, bjmask);
}

template <class Epi, class Sched, bool ALIGN_EPI = false, bool SP2 = false>
__device__ __forceinline__ void gemm_phase(PG8_LAS unsigned char* lds, const Gemm g, const Sched& S, const Epi& E) {
    const int tid = opaque_tid(), wid = __builtin_amdgcn_readfirstlane(tid >> 6), lane = tid & 63, wr = wid >> 2, wc = wid & 3, fr = lane & 15, fq = lane >> 4;
    const int K = g.K, nt = g.nt;
    unsigned voffA[2], voffB[2];
#pragma unroll
    for (int i = 0; i < 2; ++i) { int R, C; stage_rc(tid * 16 + i * 8192, R, C); const int Rb = Epi::PERM ? ((R & ~31) + perm32(R & 31)) : R;
        voffA[i] = (unsigned)(R * K + C) * 2u; voffB[i] = (unsigned)(Rb * K + C) * 2u; }
    const size_t kstep = (size_t)(BK * 2);
    const size_t hstep = (size_t)HALF * K * 2;
    const size_t tstep = 2 * hstep;
    const unsigned ldsw = (unsigned)wid * 1024u;
    const int aoff = lds_byte(wr * 64 + fr, fq * 8), boff = lds_byte(wc * 32 + fr, fq * 8);
#define PG8_SA(b, h) (((b) * 2 + (h)) * HTB)
#define PG8_SB(b, h) ((4 + (b) * 2 + (h)) * HTB)
#define PG8_STAGE(bufoff, gbase, voff) do { _Pragma("unroll") for (int _i = 0; _i < 2; ++_i) \
        __builtin_amdgcn_global_load_lds((const unsigned*)((const char*)(gbase) + (voff)[_i]), (PG8_LAS unsigned*)(lds + (bufoff) + ldsw + _i * 8192), 16, 0, 0); } while (0)
#define PG8_LDA(dst, b, h) do { _Pragma("unroll") for (int m = 0; m < 4; ++m) _Pragma("unroll") for (int k = 0; k < 2; ++k) dst[m][k] = *(const PG8_LAS bf16x8*)(lds + PG8_SA(b, h) + aoff + m * 2048 + k * 1024); } while (0)
#define PG8_LDB(dst, b, h) do { _Pragma("unroll") for (int n = 0; n < 2; ++n) _Pragma("unroll") for (int k = 0; k < 2; ++k) dst[n][k] = *(const PG8_LAS bf16x8*)(lds + PG8_SB(b, h) + boff + n * 2048 + k * 1024); } while (0)
#define PG8_MMA(ai, bj, At, Bt) do { __builtin_amdgcn_s_setprio(1); _Pragma("unroll") for (int m = 0; m < 4; ++m) _Pragma("unroll") for (int n = 0; n < 2; ++n) _Pragma("unroll") for (int k = 0; k < 2; ++k) \
        acc[ai][bj][m][n] = mfma16(Bt[n][k], At[m][k], acc[ai][bj][m][n], 0, 0, 0); __builtin_amdgcn_s_setprio(0); } while (0)
#define PG8_WAIT_V(n) asm volatile("s_waitcnt vmcnt(" #n ")" ::: "memory")
#define PG8_WAIT_L(n) asm volatile("s_waitcnt lgkmcnt(" #n ")" ::: "memory")
#define PG8_BAR __builtin_amdgcn_s_barrier()
#define PG8_SCHED __builtin_amdgcn_sched_barrier(0)
    Unit cur, nxt; int ui = 0;
    if (!S.next(0, cur)) return;
    f32x4 acc[2][2][4][2];
#pragma unroll
    for (int a = 0; a < 2; ++a)
#pragma unroll
        for (int b = 0; b < 2; ++b)
#pragma unroll
            for (int m = 0; m < 4; ++m)
#pragma unroll
                for (int n = 0; n < 2; ++n) acc[a][b][m][n] = (f32x4){0.f, 0.f, 0.f, 0.f};
    bf16x8 At[4][2], B0[2][2], B1[2][2];
    const size_t kpstep = (size_t)nt * kstep;
    const char* cA = (const char*)g.A + (size_t)cur.pm * tstep + (size_t)cur.kp * kpstep; const char* cB = (const char*)g.Bt + (size_t)cur.pn * tstep + (size_t)cur.kp * kpstep;
    S.a_ready(cur);
    if constexpr (SP2) {
        PG8_STAGE(PG8_SB(0, 0), cB, voffB); PG8_STAGE(PG8_SB(0, 1), cB + hstep, voffB); PG8_STAGE(PG8_SA(0, 0), cA, voffA); PG8_STAGE(PG8_SA(0, 1), cA + hstep, voffA);
        if (wr == 1) PG8_BAR;
        PG8_WAIT_V(2); PG8_BAR;
        PG8_STAGE(PG8_SB(1, 0), cB + kstep, voffB); PG8_STAGE(PG8_SA(1, 0), cA + kstep, voffA); PG8_STAGE(PG8_SB(1, 1), cB + hstep + kstep, voffB);
        PG8_WAIT_V(6); PG8_BAR;
    } else {
        PG8_STAGE(PG8_SB(0, 0), cB, voffB); PG8_STAGE(PG8_SA(0, 0), cA, voffA); PG8_STAGE(PG8_SB(0, 1), cB + hstep, voffB); PG8_STAGE(PG8_SA(0, 1), cA + hstep, voffA);
        if (wr == 1) PG8_BAR;
        PG8_WAIT_V(4); PG8_BAR;
        PG8_STAGE(PG8_SB(1, 0), cB + kstep, voffB); PG8_STAGE(PG8_SA(1, 0), cA + kstep, voffA); PG8_STAGE(PG8_SB(1, 1), cB + hstep + kstep, voffB);
        PG8_WAIT_V(6); PG8_BAR;
    }
    for (;;) {
        const bool has_next = S.next(ui + 1, nxt);
        const char* nA = has_next ? (const char*)g.A + (size_t)nxt.pm * tstep + (size_t)nxt.kp * kpstep : cA; const char* nB = has_next ? (const char*)g.Bt + (size_t)nxt.pn * tstep + (size_t)nxt.kp * kpstep : cB;
        for (int t = 0; t < nt; t += 2) {
            const bool last = (t == nt - 2);
            const char* a1 = cA + (size_t)(t + 1) * kstep;
            const char* a2 = last ? nA : cA + (size_t)(t + 2) * kstep; const char* b2 = last ? nB : cB + (size_t)(t + 2) * kstep;
            const char* a3 = a2 + kstep; const char* b3 = b2 + kstep;
            if (last && has_next) S.a_ready(nxt);
            if constexpr (SP2) {
            PG8_LDB(B0, 0, 0); PG8_LDB(B1, 0, 1); PG8_SCHED; PG8_LDA(At, 0, 0); PG8_STAGE(PG8_SA(1, 1), a1 + hstep, voffA);
            PG8_WAIT_V(8); PG8_WAIT_L(0); PG8_BAR; PG8_MMA(0, 0, At, B0); PG8_MMA(0, 1, At, B1); PG8_BAR; PG8_SCHED;
            PG8_LDA(At, 0, 1); PG8_STAGE(PG8_SB(0, 0), b2, voffB); PG8_STAGE(PG8_SB(0, 1), b2 + hstep, voffB); PG8_STAGE(PG8_SA(0, 0), a2, voffA);
            PG8_WAIT_V(8); PG8_WAIT_L(0); PG8_BAR; PG8_MMA(1, 0, At, B0); PG8_MMA(1, 1, At, B1); PG8_BAR; PG8_SCHED;
            PG8_LDB(B0, 1, 0); PG8_LDB(B1, 1, 1); PG8_SCHED; PG8_LDA(At, 1, 0); PG8_STAGE(PG8_SA(0, 1), a2 + hstep, voffA);
            PG8_WAIT_V(8); PG8_WAIT_L(0); PG8_BAR; PG8_MMA(0, 0, At, B0); PG8_MMA(0, 1, At, B1); PG8_BAR; PG8_SCHED;
            PG8_LDA(At, 1, 1); PG8_STAGE(PG8_SB(1, 0), b3, voffB); PG8_STAGE(PG8_SB(1, 1), b3 + hstep, voffB); PG8_STAGE(PG8_SA(1, 0), a3, voffA);
            PG8_WAIT_V(8); PG8_WAIT_L(0); PG8_BAR; PG8_MMA(1, 0, At, B0); PG8_MMA(1, 1, At, B1); PG8_BAR; PG8_SCHED;
            } else {
            PG8_LDB(B0, 0, 0); PG8_SCHED; PG8_LDA(At, 0, 0); PG8_STAGE(PG8_SA(1, 1), a1 + hstep, voffA);
            PG8_WAIT_L(8); PG8_BAR; PG8_WAIT_L(0); PG8_MMA(0, 0, At, B0); PG8_BAR; PG8_SCHED;
            PG8_LDB(B1, 0, 1); PG8_STAGE(PG8_SB(0, 0), b2, voffB);
            PG8_BAR; PG8_WAIT_L(0); PG8_MMA(0, 1, At, B1); PG8_BAR;
            PG8_LDA(At, 0, 1); PG8_STAGE(PG8_SA(0, 0), a2, voffA);
            PG8_BAR; PG8_WAIT_L(0); PG8_MMA(1, 0, At, B0); PG8_BAR; PG8_SCHED;
            PG8_STAGE(PG8_SB(0, 1), b2 + hstep, voffB);
            PG8_WAIT_V(6); PG8_BAR; PG8_MMA(1, 1, At, B1); PG8_BAR;
            PG8_LDB(B0, 1, 0); PG8_SCHED; PG8_LDA(At, 1, 0); PG8_STAGE(PG8_SA(0, 1), a2 + hstep, voffA);
            PG8_WAIT_L(8); PG8_BAR; PG8_WAIT_L(0); PG8_MMA(0, 0, At, B0); PG8_BAR; PG8_SCHED;
            PG8_LDB(B1, 1, 1); PG8_STAGE(PG8_SB(1, 0), b3, voffB);
            PG8_BAR; PG8_WAIT_L(0); PG8_MMA(0, 1, At, B1); PG8_BAR;
            PG8_LDA(At, 1, 1); PG8_STAGE(PG8_SA(1, 0), a3, voffA);
            PG8_BAR; PG8_WAIT_L(0); PG8_MMA(1, 0, At, B0); PG8_BAR; PG8_SCHED;
            PG8_STAGE(PG8_SB(1, 1), b3 + hstep, voffB);
            PG8_WAIT_V(6); PG8_BAR; PG8_MMA(1, 1, At, B1); PG8_BAR;
            }
        }
        if constexpr (ALIGN_EPI) { if (wr == 0) PG8_BAR; }
        if constexpr (!Epi::AFTER_DRAIN) { E(acc, cur, wr, wc, fr, fq); S.done(cur); }
        if (!has_next) break;
#pragma unroll
        for (int a = 0; a < 2; ++a)
#pragma unroll
            for (int b = 0; b < 2; ++b)
#pragma unroll
                for (int m = 0; m < 4; ++m)
#pragma unroll
                    for (int n = 0; n < 2; ++n) acc[a][b][m][n] = (f32x4){0.f, 0.f, 0.f, 0.f};
        cur = nxt; cA = nA; cB = nB; ++ui;
        if constexpr (ALIGN_EPI) { if (wr == 1) PG8_BAR; }
    }
    PG8_WAIT_V(0);
    if constexpr (!ALIGN_EPI) { if (wr == 0) PG8_BAR; }
    PG8_BAR;
    if constexpr (Epi::AFTER_DRAIN) { E.fused(acc, cur, wr, wc, fr, fq, lds, wid, lane); S.done(cur); }
#undef PG8_SA
#undef PG8_SB
#undef PG8_STAGE
#undef PG8_LDA
#undef PG8_LDB
#undef PG8_MMA
#undef PG8_WAIT_V
#undef PG8_WAIT_L
#undef PG8_BAR
#undef PG8_SCHED
}
}

constexpr int M = 8192, DM = 2048, SEQ = 2048, DFF = 5632, NH = 32, NKV = 4, HD = 64;
constexpr int NWAVES = 8, NTHREADS = 512;
constexpr size_t MiB = 1u << 20;
constexpr size_t WS_HSTAT = 1 * MiB, WS_VSTAT = 2 * MiB;
constexpr size_t WS_AIN = 4 * MiB;
constexpr size_t WS_AOUT = 36 * MiB;
constexpr size_t WS_FUP = 52 * MiB;
constexpr size_t WS_FDN = 228 * MiB;
constexpr size_t WS_Q0 = 316 * MiB;
constexpr size_t WS_Q1 = 326 * MiB;
constexpr size_t WS_WO = 334 * MiB;
constexpr size_t WS_HB = 350 * MiB;
constexpr size_t WS_B1 = 382 * MiB;
constexpr size_t WS_B2 = 414 * MiB;
constexpr size_t WS_B3 = 446 * MiB;
constexpr size_t WS_ACT = 478 * MiB;
constexpr size_t WS_KV = 566 * MiB;
constexpr size_t WS_LO = 638 * MiB;
constexpr size_t WS_XB = 574 * MiB;
constexpr size_t WS_END = 670 * MiB;
constexpr size_t CTL_CENSUS = 49152;
constexpr size_t CTL_FLAGS = 32768;
constexpr int LDS_BYTES = 147456;
constexpr int N_PHASES = 22;
constexpr int TAB_OFF = 131072;
constexpr int MISC_OFF = 140 * 1024;
constexpr size_t CTL_ZERO_BYTES = 65536;

#define LAS __attribute__((address_space(3)))
#define KAS __attribute__((address_space(4)))
typedef const float* cfp;
typedef const KAS cfp* kin_t;
typedef unsigned short bf16;
typedef unsigned v4u __attribute__((ext_vector_type(4)));
typedef unsigned v2u __attribute__((ext_vector_type(2)));
typedef float f32x4 __attribute__((ext_vector_type(4)));
typedef short bf16x8 __attribute__((ext_vector_type(8)));
#define LDS_WAIT() asm volatile("s_waitcnt lgkmcnt(0)" ::: "memory")
__device__ __forceinline__ unsigned pk2(float lo, float hi) { return pg8::cvt_pk_bf16(lo, hi); }
__device__ __forceinline__ float bf2f(unsigned short b) { return __uint_as_float((unsigned)b << 16); }
__device__ __forceinline__ float wave_sum(float v) {
#pragma unroll
    for (int o = 1; o < 64; o <<= 1) v += __shfl_xor(v, o);
    return v;
}

#define XB_TMO      128
#define XB_XCNT(j)  (256  + 64 * (j))
#define XB_XSUB(j)  (1280 + 64 * (j))
#define XB_XGEN(j)  (2304 + 64 * (j))
#define XB_TOP      3328
#define XB_TOPGEN   3392
#define XCD_BAR_WORDS 3456
#define XB_SPIN_CAP (1u << 18)

__device__ __forceinline__ unsigned xb_ld(unsigned* p)              { return __hip_atomic_load(p, __ATOMIC_RELAXED, __HIP_MEMORY_SCOPE_AGENT); }
__device__ __forceinline__ unsigned xb_add(unsigned* p, unsigned v) { return __hip_atomic_fetch_add(p, v, __ATOMIC_RELAXED, __HIP_MEMORY_SCOPE_AGENT); }
__device__ __forceinline__ unsigned xb_xcc_id() { return (unsigned)__builtin_amdgcn_s_getreg((3 << 11) | 20) & 0xFu; }
#define XB_SPIN(cond, bar) do { unsigned _sp = 0; while (cond) { __builtin_amdgcn_s_sleep(1); \
    if ((++_sp & 255u) == 0u) { if (xb_ld(&(bar)[XB_TMO])) break; if (_sp > XB_SPIN_CAP) { atomicAdd(&(bar)[XB_TMO], 1u); break; } } } } while (0)

struct XcdBarrier {
    unsigned* bar; unsigned x;
    volatile LAS unsigned* st;
};

__device__ __forceinline__ XcdBarrier xcd_barrier_post(unsigned* bar, volatile LAS unsigned* st) {
    XcdBarrier b; b.bar = bar; b.x = xb_xcc_id(); b.st = st;
    if (threadIdx.x == 0) (void)xb_add(&bar[XB_XCNT(b.x)], 1u);
    return b;
}
__device__ __forceinline__ void xcd_barrier_complete(unsigned* bar, unsigned x, unsigned& nloc, unsigned& nx) {
    const unsigned G = gridDim.x * gridDim.y * gridDim.z;
    unsigned sum, cnt, mine, sp = 0u;
    for (;;) {
        sum = 0u; cnt = 0u; mine = 0u;
#pragma unroll
        for (unsigned j = 0; j < 16; ++j) { const unsigned c = xb_ld(&bar[XB_XCNT(j)]); sum += c; cnt += (c > 0u) ? 1u : 0u; mine = (j == x) ? c : mine; }
        if (sum == G) break;
        __builtin_amdgcn_s_sleep(1);
        if ((++sp & 255u) == 0u) { if (xb_ld(&bar[XB_TMO])) break; if (sp > XB_SPIN_CAP) { atomicAdd(&bar[XB_TMO], 1u); break; } }
    }
    nloc = mine > 0u ? mine : 1u; nx = cnt > 0u ? cnt : 1u;
}

__device__ __forceinline__ void xcd_barrier(const XcdBarrier& b) {
    asm volatile("s_waitcnt vmcnt(0)" ::: "memory");
    __syncthreads();
    if (threadIdx.x == 0) {
        unsigned* bar = b.bar;
        __builtin_amdgcn_s_waitcnt(0);
        unsigned nloc = b.st[0], nx = b.st[1];
        if (nloc == 0u) { xcd_barrier_complete(bar, b.x, nloc, nx); b.st[0] = nloc; b.st[1] = nx; }
        const unsigned old = xb_add(&bar[XB_XSUB(b.x)], 1u);
        const unsigned gen = old / nloc;
        if (old + 1u == (gen + 1u) * nloc) {
            __builtin_amdgcn_fence(__ATOMIC_RELEASE, "agent");
            asm volatile("s_waitcnt vmcnt(0)" ::: "memory");
            const unsigned og = xb_add(&bar[XB_TOP], 1u);
            const unsigned tg = og / nx;
            if (og + 1u == (tg + 1u) * nx) xb_add(&bar[XB_TOPGEN], 1u);
            else XB_SPIN(xb_ld(&bar[XB_TOPGEN]) == tg, bar);
            __builtin_amdgcn_fence(__ATOMIC_ACQUIRE, "agent");
            xb_add(&bar[XB_XGEN(b.x)], 1u);
            asm volatile("s_waitcnt vmcnt(0)" ::: "memory");
        } else {
            XB_SPIN(xb_ld(&bar[XB_XGEN(b.x)]) == gen, bar);
            __builtin_amdgcn_fence(__ATOMIC_ACQUIRE, "agent");
            asm volatile("s_waitcnt vmcnt(0)" ::: "memory");
        }
    }
    __syncthreads();
}

__device__ __forceinline__ void xcd_barrier_local(const XcdBarrier& b) {
    asm volatile("s_waitcnt vmcnt(0)" ::: "memory");
    __syncthreads();
    if (threadIdx.x == 0) {
        unsigned* bar = b.bar;
        __builtin_amdgcn_s_waitcnt(0);
        unsigned nloc = b.st[0], nx = b.st[1];
        if (nloc == 0u) { xcd_barrier_complete(bar, b.x, nloc, nx); b.st[0] = nloc; b.st[1] = nx; }
        const unsigned old = xb_add(&bar[XB_XSUB(b.x)], 1u);
        const unsigned gen = old / nloc;
        if (old + 1u == (gen + 1u) * nloc) xb_add(&bar[XB_XGEN(b.x)], 1u);
        else XB_SPIN(xb_ld(&bar[XB_XGEN(b.x)]) == gen, bar);
        __builtin_amdgcn_fence(__ATOMIC_ACQUIRE, "agent");
        asm volatile("s_waitcnt vmcnt(0)" ::: "memory");
    }
    __syncthreads();
}

__device__ __forceinline__ void tr_item(const float* W, int K, int N, bf16* WT, int k0, int n0, int drow0, const float* gain, LAS float* scr, int lane) {
    const int lr = lane >> 4, lc = 4 * (lane & 15);
    f32x4 wv[16];
#pragma unroll
    for (int i = 0; i < 16; ++i) wv[i] = *(const f32x4*)(W + (size_t)(k0 + 4 * i + lr) * N + n0 + lc);
#pragma unroll
    for (int i = 0; i < 16; ++i) { LAS float* d = scr + (4 * i + lr) * 65 + lc; d[0] = wv[i][0]; d[1] = wv[i][1]; d[2] = wv[i][2]; d[3] = wv[i][3]; }
    LDS_WAIT();
    const int c = lane & 7;
    f32x4 g0 = {1.f, 1.f, 1.f, 1.f}, g1 = {1.f, 1.f, 1.f, 1.f};
    if (gain) { g0 = *(const f32x4*)(gain + k0 + 8 * c); g1 = *(const f32x4*)(gain + k0 + 8 * c + 4); }
#pragma unroll
    for (int j = 0; j < 8; ++j) {
        const int n = (lane >> 3) + 8 * j; const LAS float* s = scr + (8 * c) * 65 + n;
        v4u o; o.x = pk2(s[0 * 65] * g0[0], s[1 * 65] * g0[1]); o.y = pk2(s[2 * 65] * g0[2], s[3 * 65] * g0[3]);
        o.z = pk2(s[4 * 65] * g1[0], s[5 * 65] * g1[1]); o.w = pk2(s[6 * 65] * g1[2], s[7 * 65] * g1[3]);
        *(v4u*)(WT + (size_t)(drow0 + n) * K + k0 + 8 * c) = o;
    }
    LDS_WAIT();
}
__device__ __forceinline__ void tr_mat(const float* W, int K, int N, bf16* WT, int item, const float* gain, int mode  , LAS float* scr, int lane) {
    const int nblk = N >> 6; const int kb = item / nblk, nb = item - kb * nblk; const int n0 = nb * 64;
    int drow0 = n0;
    if (mode) drow0 = (n0 >> 7) * 256 + (n0 & 127) + (mode == 2 ? 128 : 0);
    tr_item(W, K, N, WT, kb * 64, n0, drow0, gain, scr, lane);
}

__device__ __forceinline__ int mat_items(int id) { return id < 2 ? 32 * 64 : id < 4 ? 32 * 32 : id < 16 ? 32 * 88 : id == 16 ? 32 * 8 : 32 * 32; }
__device__ __forceinline__ void convert_item(int id, int r, kin_t in, unsigned char* ws, LAS float* scr, int lane) {
    const float* mixn = in[1]; const float* ffnn = in[2];
    if (id < 2) tr_mat(in[3] + (size_t)id * DM * 4096, DM, 4096, (bf16*)(ws + WS_AIN + (size_t)id * 16 * MiB), r, mixn + id * DM, 0, scr, lane);
    else if (id < 4) tr_mat(in[7] + (size_t)(id - 2) * DM * DM, DM, DM, (bf16*)(ws + WS_AOUT + (size_t)(id - 2) * 8 * MiB), r, nullptr, 0, scr, lane);
    else if (id < 8) tr_mat(in[17] + (size_t)(id - 4) * DM * DFF, DM, DFF, (bf16*)(ws + WS_FUP + (size_t)(id - 4) * 44 * MiB), r, ffnn + (id - 4) * DM, 1, scr, lane);
    else if (id < 12) tr_mat(in[18] + (size_t)(id - 8) * DM * DFF, DM, DFF, (bf16*)(ws + WS_FUP + (size_t)(id - 8) * 44 * MiB), r, ffnn + (id - 8) * DM, 2, scr, lane);
    else if (id < 16) tr_mat(in[19] + (size_t)(id - 12) * DFF * DM, DFF, DM, (bf16*)(ws + WS_FDN + (size_t)(id - 12) * 22 * MiB), r, nullptr, 0, scr, lane);
    else if (id == 16) tr_mat(in[9], DM, 512, (bf16*)(ws + WS_Q0) + (size_t)2048 * DM, r, in[8], 0, scr, lane);
    else if (id < 19) tr_mat(in[11] + (size_t)(id - 17) * DM * DM, DM, DM, (bf16*)(ws + (id == 18 ? WS_Q1 : WS_Q0)), r, mixn + (2 + id - 17) * DM, 0, scr, lane);
    else tr_mat(in[14] + (size_t)(id - 19) * DM * DM, DM, DM, (bf16*)(ws + WS_WO + (size_t)(id - 19) * 8 * MiB), r, nullptr, 0, scr, lane);
}
__device__ __forceinline__ void convert_set(LAS unsigned char* lds, kin_t in, unsigned char* ws, unsigned long long set, int widx, int nworkers) {
    const int tid = opaque_tid(), lane = tid & 63, wave = __builtin_amdgcn_readfirstlane(tid >> 6);
    LAS float* scr = (LAS float*)(lds + wave * 16640);
    int base = 0;
    for (; (set & 31ull) != 31ull; set >>= 5) {
        const int id = (int)(set & 31ull), n = mat_items(id);
        int start = (widx - base) % nworkers; if (start < 0) start += nworkers;
        for (int r = start; r < n; r += nworkers) convert_item(id, r, in, ws, scr, lane);
        base += n;
    }
}
#define MSET1(a) ((unsigned long long)(a) | (31ull << 5))
#define MSET3(a, b, c) ((unsigned long long)(a) | ((unsigned long long)(b) << 5) | ((unsigned long long)(c) << 10) | (31ull << 15))
#define MSET4(a, b, c, d) ((unsigned long long)(a) | ((unsigned long long)(b) << 5) | ((unsigned long long)(c) << 10) | ((unsigned long long)(d) << 15) | (31ull << 20))
#define MSET7(a, b, c, d, e, f, g) ((unsigned long long)(a) | ((unsigned long long)(b) << 5) | ((unsigned long long)(c) << 10) | ((unsigned long long)(d) << 15) | ((unsigned long long)(e) << 20) | ((unsigned long long)(f) << 25) | ((unsigned long long)(g) << 30) | (31ull << 35))
#if MK_LAZY
#define MSET5(a, b, c, d, e) ((unsigned long long)(a) | ((unsigned long long)(b) << 5) | ((unsigned long long)(c) << 10) | ((unsigned long long)(d) << 15) | ((unsigned long long)(e) << 20) | (31ull << 25))
constexpr unsigned long long SET_PRO = MSET4(0, 2, 4, 8);
constexpr unsigned long long SET_PH4 = MSET5(12, 1, 3, 9, 5), SET_PH9 = MSET4(13, 17, 16, 19), SET_PH11 = MSET3(6, 10, 7), SET_PH14 = MSET4(14, 18, 20, 11), SET_PH19 = MSET1(15);
#endif
__device__ __forceinline__ void tail_convert(LAS unsigned char* lds, kin_t in, unsigned char* ws, unsigned long long set, int nunits, int blk, int nblk) {
    const int nfull = nunits % nblk;
    if (blk < nfull) return;
    const int wave = __builtin_amdgcn_readfirstlane(threadIdx.x >> 6);
    convert_set(lds, in, ws, set, (blk - nfull) * NWAVES + wave, (nblk - nfull) * NWAVES);
}

__device__ __forceinline__ void prologue_phase(LAS unsigned char* lds, kin_t in, float* H, unsigned char* ws, int blk, int nblk) {
    const int tid = opaque_tid(), lane = tid & 63, wave = __builtin_amdgcn_readfirstlane(tid >> 6);
    const int gw = blk * NWAVES + wave, NGW = nblk * NWAVES;
#if MK_LAZY
    convert_set(lds, in, ws, SET_PRO, gw, NGW);
#else
    for (int id = 0; id < 21; ++id) convert_set(lds, in, ws, MSET1(id), gw, NGW);
#endif
    const float* x = in[0]; bf16* HB = (bf16*)(ws + WS_HB); float* hstats = (float*)(ws + WS_HSTAT);
    for (int m = gw; m < M; m += NGW) {
        const f32x4* xr = (const f32x4*)(x + (size_t)m * DM) + lane;
        v2u* hb = (v2u*)(HB + (size_t)m * DM) + lane;
        f32x4 v[8]; float s = 0.f;
#pragma unroll
        for (int j = 0; j < 8; ++j) { v[j] = xr[64 * j]; s += (v[j][0] * v[j][0] + v[j][1] * v[j][1]) + (v[j][2] * v[j][2] + v[j][3] * v[j][3]); }
        const float tot = wave_sum(s);
#pragma unroll
        for (int j = 0; j < 8; ++j) { v2u o; o.x = pk2(v[j][0], v[j][1]); o.y = pk2(v[j][2], v[j][3]); hb[64 * j] = o;
            if (MK_RESID == 3) { v2u l; l.x = pkh16(v[j][0], v[j][1]); l.y = pkh16(v[j][2], v[j][3]); ((v2u*)((bf16*)(ws + WS_LO) + (size_t)m * DM))[lane + 64 * j] = l; }
            if (MK_RESID == 2) { v2u l; l.x = pk2(v[j][0] - unpk_lo(o.x), v[j][1] - unpk_hi(o.x)); l.y = pk2(v[j][2] - unpk_lo(o.y), v[j][3] - unpk_hi(o.y)); ((v2u*)((bf16*)(ws + WS_LO) + (size_t)m * DM))[lane + 64 * j] = l; } }
        if (lane < 32) hstats[(size_t)m * 32 + lane] = (lane == 0) ? tot : 0.f;
    }
}

__device__ __forceinline__ void final_phase(float* H, const bf16* HB, const bf16* LO, const float* hstats, const float* fn, int blk, int nblk, int nmax) {
    const int tid = opaque_tid(), lane = tid & 63, wave = tid >> 6;
    const int gw = blk * NWAVES + wave, NGW = nblk * NWAVES;
    if (MK_RESID == 0) {
        f32x4 g[8];
#pragma unroll
        for (int j = 0; j < 8; ++j) g[j] = ((const f32x4*)fn)[lane + 64 * j];
        for (int m = gw, it_ = 0; m < M && it_ < nmax; m += NGW, ++it_) {
            const float p = (lane < 32) ? hstats[(size_t)m * 32 + lane] : 0.f;
            const float rstd = rsqrtf(wave_sum(p) * (1.0f / 2048.0f) + 1e-5f);
            f32x4* hr = (f32x4*)(H + (size_t)m * DM) + lane;
#pragma unroll
            for (int j = 0; j < 8; ++j) { f32x4 v = hr[64 * j]; v = v * rstd * g[j]; hr[64 * j] = v; }
        }
    } else {
        f32x4 g[4][2];
#pragma unroll
        for (int j = 0; j < 4; ++j) { g[j][0] = ((const f32x4*)fn)[2 * (lane + 64 * j)]; g[j][1] = ((const f32x4*)fn)[2 * (lane + 64 * j) + 1]; }
        for (int m = gw, it_ = 0; m < M && it_ < nmax; m += NGW, ++it_) {
            v4u hb[4], lo[4];
#pragma unroll
            for (int j = 0; j < 4; ++j) { hb[j] = ((const v4u*)((MK_RESID == 3 ? LO : HB) + (size_t)m * DM))[lane + 64 * j]; if (MK_RESID == 2) lo[j] = ((const v4u*)(LO + (size_t)m * DM))[lane + 64 * j]; }
            const float p = (lane < 32) ? hstats[(size_t)m * 32 + lane] : 0.f;
            const float rstd = rsqrtf(wave_sum(p) * (1.0f / 2048.0f) + 1e-5f);
            f32x4* orow = (f32x4*)(H + (size_t)m * DM);
#pragma unroll
            for (int j = 0; j < 4; ++j) {
                f32x4 a, b; if (MK_RESID == 3) pg8::h8_to_f32(hb[j], a, b); else pg8::bf8_to_f32(hb[j], a, b);
                if (MK_RESID == 2) { f32x4 c, d; pg8::bf8_to_f32(lo[j], c, d); a = a + c; b = b + d; }
                orow[2 * (lane + 64 * j)] = a * rstd * g[j][0]; orow[2 * (lane + 64 * j) + 1] = b * rstd * g[j][1];
            }
        }
    }
}

constexpr int G_RV = 0, G_WC = 1024, G_WCP = 272, G_VT = 36864, G_VTP = 528;
__device__ __forceinline__ void gate_phase(LAS unsigned char* lds, const bf16* U, const bf16* V, bf16* G, const float* vstats, const float* Ws, const float* bs, const float* gnorm, int blk, int nblk, int nmax) {
    const int tid = opaque_tid(), lane = tid & 63, wid = __builtin_amdgcn_readfirstlane(tid >> 6), l15 = lane & 15, fq = lane >> 4;
    LAS float* RV = (LAS float*)(lds + G_RV);
    for (int unit = blk, it_ = 0; unit < 512 && it_ < nmax; unit += nblk, ++it_) {
        const int chunk = unit >> 3, g = unit & 7, R0 = chunk * 128;
        const int srow = tid >> 2, sq = tid & 3;
        const f32x4* sp = (const f32x4*)(vstats + (size_t)(R0 + srow) * 32 + sq * 8);
        const f32x4 sa = sp[0], sb = sp[1];
        v4u val[8]; f32x4 wsv[8]; v2u uu[8][2]; f32x4 gn[2]; float bb[8];
#pragma unroll
        for (int i = 0; i < 8; ++i) { const int idx = i * NTHREADS + tid, s_ = idx >> 5, dc = (idx & 31) * 8; val[i] = *(const v4u*)(V + (size_t)(R0 + s_) * DM + g * 256 + dc); }
#pragma unroll
        for (int i = 0; i < 8; ++i) { const int idx = i * NTHREADS + tid, t = idx >> 5, s4 = (idx & 31) * 4; wsv[i] = *(const f32x4*)(Ws + (size_t)(g * 128 + t) * 128 + s4); }
#pragma unroll
        for (int nt = 0; nt < 2; ++nt) {
            const int col = g * 256 + 32 * wid + 16 * nt + 4 * fq;
            gn[nt] = *(const f32x4*)(gnorm + col);
#pragma unroll
            for (int mt = 0; mt < 8; ++mt) uu[mt][nt] = *(const v2u*)(U + (size_t)(R0 + 16 * mt + l15) * DM + col);
        }
#pragma unroll
        for (int mt = 0; mt < 8; ++mt) bb[mt] = bs[g * 128 + 16 * mt + l15];
        {
            float s_ = ((sa[0] + sa[1]) + (sa[2] + sa[3])) + ((sb[0] + sb[1]) + (sb[2] + sb[3]));
            s_ += __shfl_xor(s_, 1); s_ += __shfl_xor(s_, 2);
            if (sq == 0) RV[srow] = rsqrtf(s_ * (1.0f / 2048.0f) + 1e-5f);
        }
#pragma unroll
        for (int i = 0; i < 8; ++i) { const int idx = i * NTHREADS + tid, s_ = idx >> 5, dc = (idx & 31) * 8; *(LAS v4u*)(lds + G_VT + s_ * G_VTP + dc * 2) = val[i]; }
        __syncthreads();
#pragma unroll
        for (int i = 0; i < 8; ++i) {
            const int idx = i * NTHREADS + tid, t = idx >> 5, s4 = (idx & 31) * 4;
            f32x4 w = wsv[i];
            const f32x4 r = *(const LAS f32x4*)(RV + s4);
#pragma unroll
            for (int e = 0; e < 4; ++e) w[e] = (s4 + e <= t) ? w[e] * r[e] : 0.f;
            v2u o; o.x = pk2(w[0], w[1]); o.y = pk2(w[2], w[3]);
            *(LAS v2u*)(lds + G_WC + t * G_WCP + s4 * 2) = o;
        }
        __syncthreads();
        f32x4 acc[8][2];
#pragma unroll
        for (int mt = 0; mt < 8; ++mt) { acc[mt][0] = (f32x4){0.f, 0.f, 0.f, 0.f}; acc[mt][1] = (f32x4){0.f, 0.f, 0.f, 0.f}; }
#pragma unroll
        for (int ks = 0; ks < 4; ++ks) {
            bf16x8 vf[2];
#pragma unroll
            for (int nt = 0; nt < 2; ++nt)
#pragma unroll
                for (int j = 0; j < 8; ++j)
                    vf[nt][j] = (short)*(const LAS unsigned short*)(lds + G_VT + (32 * ks + 8 * fq + j) * G_VTP + (32 * wid + 16 * nt + l15) * 2);
#pragma unroll
            for (int mt = 0; mt < 8; ++mt) {
                if (2 * ks < mt + 1) {
                    const bf16x8 wf = *(const LAS bf16x8*)(lds + G_WC + (16 * mt + l15) * G_WCP + (32 * ks + 8 * fq) * 2);
                    acc[mt][0] = mfma16(vf[0], wf, acc[mt][0], 0, 0, 0);
                    acc[mt][1] = mfma16(vf[1], wf, acc[mt][1], 0, 0, 0);
                }
            }
        }
#pragma unroll
        for (int nt = 0; nt < 2; ++nt) {
            const int col = g * 256 + 32 * wid + 16 * nt + 4 * fq;
#pragma unroll
            for (int mt = 0; mt < 8; ++mt) {
                const int t = 16 * mt + l15; const float b = bb[mt];
                const v2u u2 = uu[mt][nt];
                const float u0 = unpk_lo(u2.x), u1 = unpk_hi(u2.x), u2f = unpk_lo(u2.y), u3 = unpk_hi(u2.y);
                const f32x4 a = acc[mt][nt];
                v2u o; o.x = pk2(u0 * (gn[nt][0] * a[0] + b), u1 * (gn[nt][1] * a[1] + b)); o.y = pk2(u2f * (gn[nt][2] * a[2] + b), u3 * (gn[nt][3] * a[3] + b));
                *(v2u*)(G + (size_t)(R0 + t) * DM + col) = o;
            }
        }
        __syncthreads();
    }
}

constexpr int A_KS = 0, A_KSP = 144, A_VT = 36864, A_VTP = 528, A_LUT = 70656;
__device__ __forceinline__ void attn_phase(LAS unsigned char* lds, const bf16* Q, const bf16* KV, bf16* O, const float* sinks, const float* rel_bias, int blk, int nblk, int nmax) {
    const int tid = opaque_tid(), lane = tid & 63, wid = __builtin_amdgcn_readfirstlane(tid >> 6), l15 = lane & 15, fq = lane >> 4;
    LAS float* LUT = (LAS float*)(lds + A_LUT);
    constexpr float LOG2E = 1.4426950408889634f;
    for (int unit = blk, it_ = 0; unit < 256 && it_ < nmax; unit += nblk, ++it_) {
        const int hk = unit & 3, c = (unit >> 2) & 15, b = unit >> 6;
        const int rowq0 = b * SEQ + c * 128, rowk0 = rowq0 - 128;
        v4u kva[4], vva[4];
#pragma unroll
        for (int i = 0; i < 4; ++i) {
            const int idx = i * NTHREADS + tid, kk = idx >> 3, c8 = idx & 7;
            const bool ok = (c > 0) || (kk >= 128);
            kva[i] = (v4u){0u, 0u, 0u, 0u}; vva[i] = (v4u){0u, 0u, 0u, 0u};
            if (ok) { const bf16* p = KV + (size_t)(rowk0 + kk) * 512 + hk * 64 + c8 * 8; kva[i] = *(const v4u*)p; vva[i] = *(const v4u*)(p + 256); }
        }
#pragma unroll
        for (int i = 0; i < 4; ++i) {
            const int idx = i * NTHREADS + tid, kk = idx >> 3, c8 = idx & 7;
            const v4u kv = kva[i], vv = vva[i];
            *(LAS v4u*)(lds + A_KS + kk * A_KSP + c8 * 16) = kv;
            const int kp = (kk & ~31) + ((kk >> 2) & 3) * 8 + ((kk >> 4) & 1) * 4 + (kk & 3);
            LAS unsigned short* vt = (LAS unsigned short*)(lds + A_VT + (c8 * 8) * A_VTP + kp * 2);
            vt[0 * (A_VTP / 2)] = (unsigned short)(vv.x & 0xffffu); vt[1 * (A_VTP / 2)] = (unsigned short)(vv.x >> 16);
            vt[2 * (A_VTP / 2)] = (unsigned short)(vv.y & 0xffffu); vt[3 * (A_VTP / 2)] = (unsigned short)(vv.y >> 16);
            vt[4 * (A_VTP / 2)] = (unsigned short)(vv.z & 0xffffu); vt[5 * (A_VTP / 2)] = (unsigned short)(vv.z >> 16);
            vt[6 * (A_VTP / 2)] = (unsigned short)(vv.w & 0xffffu); vt[7 * (A_VTP / 2)] = (unsigned short)(vv.w >> 16);
        }
#pragma unroll
        for (int i = 0; i < 3; ++i) {
            const int idx = i * NTHREADS + tid, hh = idx / 192, dist = idx - hh * 192 - 32;
            float val = -1e30f;
            if (dist >= 0 && dist < 128) {
                int bucket = dist;
                if (dist >= 16) { bucket = 16 + (int)(__log2f((float)dist * 0.0625f) * (16.0f / 3.0f)); bucket = bucket > 31 ? 31 : bucket; }
                val = rel_bias[bucket * NH + hk * 8 + hh] * LOG2E;
            }
            LUT[idx] = val;
        }
        __syncthreads();
        const int h = hk * 8 + wid; const float sink = sinks[h] * LOG2E;
        const LAS float* lutb = LUT + wid * 192 + 32 + l15 + 128 - 4 * fq;
        const bf16* qbase = Q + (size_t)(rowq0 + l15) * DM + h * 64 + 8 * fq;
        bf16x8 qall[8][2];
#pragma unroll
        for (int t = 0; t < 8; ++t) { qall[t][0] = *(const bf16x8*)(qbase + (size_t)(16 * t) * DM); qall[t][1] = *(const bf16x8*)(qbase + (size_t)(16 * t) * DM + 32); }
#pragma unroll
        for (int qp = 0; qp < 4; ++qp) {
            const int kt0 = 2 * qp;
            bf16x8 qf[2][2];
#pragma unroll
            for (int t = 0; t < 2; ++t) { qf[t][0] = qall[2 * qp + t][0]; qf[t][1] = qall[2 * qp + t][1]; }
            f32x4 acc[2][10];
            const LAS unsigned char* kb = lds + A_KS + (16 * kt0 + l15) * A_KSP + 16 * fq;
#pragma unroll
            for (int r = 0; r < 10; ++r) {
                const LAS unsigned char* kp = kb + r * 16 * A_KSP;
                const bf16x8 k0 = *(const LAS bf16x8*)kp, k1 = *(const LAS bf16x8*)(kp + 64);
#pragma unroll
                for (int t = 0; t < 2; ++t) {
                    f32x4 z = {0.f, 0.f, 0.f, 0.f};
                    z = mfma16(k0, qf[t][0], z, 0, 0, 0);
                    acc[t][r] = mfma16(k1, qf[t][1], z, 0, 0, 0);
                }
            }
            float inv[2];
#pragma unroll
            for (int t = 0; t < 2; ++t) {
                float mx = -1e30f;
                float lb[10][4];
#pragma unroll
                for (int r = 0; r < 10; ++r)
#pragma unroll
                    for (int j = 0; j < 4; ++j) lb[r][j] = lutb[16 * (t - r) - j];
#pragma unroll
                for (int r = 0; r < 10; ++r) {
                    const float pen = ((c == 0) && (kt0 + r < 8)) ? -1e30f : 0.f;
#pragma unroll
                    for (int j = 0; j < 4; ++j) {
                        const float sc = acc[t][r][j] + (lb[r][j] + pen);
                        acc[t][r][j] = sc; mx = fmaxf(mx, sc);
                    }
                }
                mx = fmaxf(mx, __shfl_xor(mx, 16)); mx = fmaxf(mx, __shfl_xor(mx, 32)); mx = fmaxf(mx, sink);
                float sum = 0.f;
#pragma unroll
                for (int r = 0; r < 10; ++r)
#pragma unroll
                    for (int j = 0; j < 4; ++j) { const float pe = __builtin_amdgcn_exp2f(acc[t][r][j] - mx); acc[t][r][j] = pe; sum += pe; }
                sum += __shfl_xor(sum, 16); sum += __shfl_xor(sum, 32);
                sum += __builtin_amdgcn_exp2f(sink - mx);
                inv[t] = 1.0f / sum;
            }
            f32x4 o[2][4];
#pragma unroll
            for (int t = 0; t < 2; ++t)
#pragma unroll
                for (int dt = 0; dt < 4; ++dt) o[t][dt] = (f32x4){0.f, 0.f, 0.f, 0.f};
            const LAS unsigned char* vb = lds + A_VT + l15 * A_VTP + (32 * qp + 8 * fq) * 2;
#pragma unroll
            for (int cs = 0; cs < 5; ++cs) {
                bf16x8 pf[2];
#pragma unroll
                for (int t = 0; t < 2; ++t) {
                    v4u pw; pw.x = pk2(acc[t][2 * cs][0], acc[t][2 * cs][1]); pw.y = pk2(acc[t][2 * cs][2], acc[t][2 * cs][3]); pw.z = pk2(acc[t][2 * cs + 1][0], acc[t][2 * cs + 1][1]); pw.w = pk2(acc[t][2 * cs + 1][2], acc[t][2 * cs + 1][3]);
                    pf[t] = __builtin_bit_cast(bf16x8, pw);
                }
#pragma unroll
                for (int dt = 0; dt < 4; ++dt) {
                    const bf16x8 vf = *(const LAS bf16x8*)(vb + (16 * dt) * A_VTP + cs * 64);
                    o[0][dt] = mfma16(vf, pf[0], o[0][dt], 0, 0, 0);
                    o[1][dt] = mfma16(vf, pf[1], o[1][dt], 0, 0, 0);
                }
            }
#pragma unroll
            for (int t = 0; t < 2; ++t) {
                bf16* op = O + (size_t)(rowq0 + 16 * (2 * qp + t) + l15) * DM + h * 64 + 4 * fq;
#pragma unroll
                for (int dt = 0; dt < 4; ++dt) { v2u w; w.x = pk2(o[t][dt][0] * inv[t], o[t][dt][1] * inv[t]); w.y = pk2(o[t][dt][2] * inv[t], o[t][dt][3] * inv[t]); *(v2u*)(op + 16 * dt) = w; }
            }
        }
        __syncthreads();
    }
}

struct Args { const float* in[21]; float* out; unsigned char* ws; int ph_lo, ph_hi; };
__global__ void __launch_bounds__(NTHREADS, 2) mk_fwd(Args a_unused) {
    extern __shared__ __attribute__((aligned(16))) unsigned char lds_raw[];
    LAS unsigned char* lds = (LAS unsigned char*)lds_raw;
    int blk = blockIdx.x; const int nblk = gridDim.x; bool xl = false;
    const KAS Args* ap = (const KAS Args*)__builtin_amdgcn_kernarg_segment_ptr();
    const int ph_hi = ap->ph_hi;
#if MK_COOP
    volatile LAS unsigned* MISC = (volatile LAS unsigned*)(lds + MISC_OFF);
    if (threadIdx.x < 2) MISC[threadIdx.x] = 0u;
    __syncthreads();
    XcdBarrier bar = xcd_barrier_post((unsigned*)ap->ws, MISC);
#if MK_XLOCAL
    if (threadIdx.x == 0) {
        typedef __attribute__((address_space(1))) unsigned gu32_;
        gu32_* cen = (gu32_*)((unsigned*)(ap->ws + CTL_CENSUS));
        const unsigned x = xb_xcc_id();
        const unsigned rank = __hip_atomic_fetch_add(cen + 64 * x, 1u, __ATOMIC_RELAXED, __HIP_MEMORY_SCOPE_AGENT);
        unsigned cnt[16], sp = 0; bool done = false;
        while (!done) {
            unsigned sum = 0;
#pragma unroll
            for (int j = 0; j < 16; ++j) { cnt[j] = __hip_atomic_load(cen + 64 * j, __ATOMIC_RELAXED, __HIP_MEMORY_SCOPE_AGENT); sum += cnt[j]; }
            done = (sum == (unsigned)nblk);
            if (!done) { __builtin_amdgcn_s_sleep(1); if (++sp > (1u << 20)) break; }
        }
        bool ok = done && (nblk == 256); unsigned npop = 0, xidx = 0;
#pragma unroll
        for (int j = 0; j < 16; ++j) { if (cnt[j]) { ++npop; if (cnt[j] != 32u) ok = false; if ((unsigned)j < x) ++xidx; } }
        ok = ok && (npop == 8);
        MISC[2] = ok ? rank * 8u + xidx : (unsigned)blockIdx.x; MISC[3] = ok ? 1u : 0u;
    }
    __syncthreads();
    blk = __builtin_amdgcn_readfirstlane((int)MISC[2]); xl = __builtin_amdgcn_readfirstlane((int)MISC[3]) != 0;
#endif
#endif
    for (int ph = ap->ph_lo; ph < ph_hi; ++ph) {
        const KAS Args* p = ap; asm volatile("" : "+s"(p));
        unsigned char* ws = p->ws;
        float* H = p->out; bf16* HB = (bf16*)(ws + WS_HB);
        float* hstats = (float*)(ws + WS_HSTAT); float* vstats = (float*)(ws + WS_VSTAT);
        bf16* B1 = (bf16*)(ws + WS_B1); bf16* B2 = (bf16*)(ws + WS_B2); bf16* B3 = (bf16*)(ws + WS_B3);
        bf16* ACT = (bf16*)(ws + WS_ACT); bf16* KVB = (bf16*)(ws + WS_KV);
        float* xbuf = (float*)(ws + WS_XB); unsigned* sflags = (unsigned*)(ws + CTL_FLAGS);
        const bool split_ok = MK_SPLIT && (nblk == 256);
        int nrep = 1;
#ifdef MK_PROBE
        { const int sub_ = (ph - 1) % 5; const bool mid = ph > 0 && ph < N_PHASES - 1;
          if ((MK_PROBE & 1) && ph == 0) nrep = 2;
          if ((MK_PROBE & 2) && mid && sub_ == 1) nrep = 2;
          if ((MK_PROBE & 4) && mid && sub_ == 3) nrep = 2;
          if ((MK_PROBE & 8) && mid && sub_ == 0) nrep = 2; }
#endif
        for (int rep = 0; rep < nrep; ++rep) {
        if (ph == 0) prologue_phase(lds, p->in, H, ws, blk, nblk);
        else if (ph == N_PHASES - 1) final_phase(H, HB, (const bf16*)(ws + WS_LO), hstats, p->in[20], xl ? 128 * (blk & 7) + (blk >> 3) : blk, xl ? 32 : nblk, xl ? 4 : (1 << 30));
        else {
            const int L = (ph - 1) / 5, sub = (ph - 1) % 5, i = L - 2;
            if (sub == 0) {
                if (L < 2) {
                    pg8::Gemm g{HB, (const bf16*)(ws + WS_AIN + (size_t)L * 16 * MiB), M, 4096, DM, DM / 64}; pg8::StaticOrder S; S.init(M, 4096, nblk, blk);
                    PG8_LAS float* tab = (PG8_LAS float*)(lds + TAB_OFF); pg8::build_ms_table(tab, hstats, S);
                    pg8::EpiGeluUV E{B1, B2, hstats, vstats, tab};
                    pg8::gemm_phase<pg8::EpiGeluUV, pg8::StaticOrder, true, true>(lds, g, S, E);
                } else {
                    const bool split = split_ok && (i == 0);
                    const int N = (i == 0 && !split) ? 2560 : 2048;
                    pg8::Gemm g{HB, (const bf16*)(ws + (i ? WS_Q1 : WS_Q0)), M, N, DM, DM / 64}; pg8::StaticOrder S; S.init(M, N, nblk, blk);
#if MK_LAZY
                    if (i == 0) { tail_convert(lds, p->in, ws, SET_PH11, split ? 256 : 320, blk, nblk); __syncthreads(); }
#endif
                    PG8_LAS float* tab = split ? (PG8_LAS float*)nullptr : (PG8_LAS float*)(lds + TAB_OFF); if (!split) pg8::build_ms_table(tab, hstats, S);
                    pg8::EpiQKV E{B1, KVB, hstats, p->in[12] + i * DM, p->in[10], 0.125f * 1.4426950408889634f, tab};
                    pg8::Unit su; pg8::SplitOrder S2{S, 0, 4, 64, 1, blk}; bool has_split = false;
                    if (split) {
                        has_split = S2.next(0, su);
                        pg8::Gemm g2{HB, (const bf16*)(ws + WS_Q0), M, 2560, DM, 8};
                        pg8::EpiStore E2{xbuf, sflags + 4 * 128, 4};
                        pg8::gemm_phase<pg8::EpiStore, pg8::SplitOrder, false, true>(lds, g2, S2, E2);
                    }
                    pg8::gemm_phase<pg8::EpiQKV, pg8::StaticOrder, true, true>(lds, g, S, E);
                    if (has_split) pg8::split_fixup(E, xbuf, sflags + 4 * 128, 4, su);
                }
            } else if (sub == 1) {
                if (L < 2) gate_phase(lds, B1, B2, B3, vstats, p->in[5] + (size_t)L * 8 * 128 * 128, p->in[6] + L * 8 * 128, p->in[4] + L * DM, xl ? 64 * (blk & 7) + (blk >> 3) : blk, xl ? 32 : nblk, xl ? 2 : (1 << 30));
                else attn_phase(lds, B1, KVB, B2, p->in[13] + i * NH, p->in[16], xl ? 32 * (blk & 7) + (blk >> 3) : blk, xl ? 32 : nblk, xl ? 1 : (1 << 30));
            } else if (sub == 3) {
                pg8::Gemm g{HB, (const bf16*)(ws + WS_FUP + (size_t)L * 44 * MiB), M, 2 * DFF, DM, DM / 64}; pg8::StaticOrder S; S.init(M, 2 * DFF, nblk, blk);
                if (split_ok) S.limit = 1280;
#if MK_LAZY
                tail_convert(lds, p->in, ws, L == 0 ? SET_PH4 : L == 1 ? SET_PH9 : L == 2 ? SET_PH14 : SET_PH19, split_ok ? 256 : 1408, blk, nblk);
                __syncthreads();
#endif
                PG8_LAS float* tab = split_ok ? (PG8_LAS float*)nullptr : (PG8_LAS float*)(lds + TAB_OFF); if (!split_ok) pg8::build_ms_table(tab, hstats, S);
                pg8::EpiSwiglu E{ACT, hstats, tab};
                pg8::Unit su; pg8::SplitOrder S2{S, 1280, 2, 128, 0, blk}; bool has_split = false;
                if (split_ok) {
                    has_split = S2.next(0, su);
                    pg8::Gemm g2{HB, (const bf16*)(ws + WS_FUP + (size_t)L * 44 * MiB), M, 2 * DFF, DM, 16};
                    pg8::EpiStore E2{xbuf, sflags + L * 128, 2};
                    pg8::gemm_phase<pg8::EpiStore, pg8::SplitOrder, false, true>(lds, g2, S2, E2);
                }
                pg8::gemm_phase<pg8::EpiSwiglu, pg8::StaticOrder, true, true>(lds, g, S, E);
                if (has_split) pg8::split_fixup(E, xbuf, sflags + L * 128, 2, su);
            } else {
                const bf16* A; const bf16* Bt; int K; const float* bias = nullptr;
                if (sub == 2) { K = DM; if (L < 2) { A = B3; Bt = (const bf16*)(ws + WS_AOUT + (size_t)L * 8 * MiB); } else { A = B2; Bt = (const bf16*)(ws + WS_WO + (size_t)i * 8 * MiB); bias = p->in[15] + i * DM; } }
                else { K = DFF; A = ACT; Bt = (const bf16*)(ws + WS_FDN + (size_t)L * 22 * MiB); }
                pg8::Gemm g{A, Bt, M, DM, K, K / 64}; pg8::StaticOrder S; S.init(M, DM, nblk, blk);
                pg8::EpiResid E{H, HB, hstats, bias, (ph == 3) ? p->in[0] : (MK_RESID == 0 ? (const float*)H : (const float*)nullptr), (bf16*)(ws + WS_LO)};
                pg8::gemm_phase<pg8::EpiResid, pg8::StaticOrder, true, true>(lds, g, S, E);
            }
        }
        }
        if (ph + 1 < ph_hi) {
#if MK_COOP
            if (ph_hi > 1000) cg::this_grid().sync();
            if (xl && !(ph == 0 || ph == 4 || ph == 9 || ph == 11 || ph == 14 || ph == 19)) xcd_barrier_local(bar); else xcd_barrier(bar);
#endif
        }
    }
}

extern "C" void kernel_launch(void* const* d_in, const int* in_sizes, int n_in, void* d_out, int out_size, void* d_ws, size_t ws_size, hipStream_t stream) {
    static int grid = 0;
    if (grid == 0) {
        if (n_in != 21 || out_size != M * DM || ws_size < WS_END) { fprintf(stderr, "kernel_launch: unexpected shapes (n_in %d out %d ws %zu)\n", n_in, out_size, ws_size); grid = -1; return; }
        int dev = 0, cus = 0, per_cu = 0;
        hipGetDevice(&dev); hipDeviceGetAttribute(&cus, hipDeviceAttributeMultiprocessorCount, dev);
        hipFuncSetAttribute((const void*)mk_fwd, hipFuncAttributeMaxDynamicSharedMemorySize, LDS_BYTES);
        if (hipOccupancyMaxActiveBlocksPerMultiprocessor(&per_cu, (const void*)mk_fwd, NTHREADS, LDS_BYTES) != hipSuccess || per_cu < 1) per_cu = 1;
        (void)hipGetLastError();
        grid = cus * per_cu;
        if (grid <= 0) grid = 256;
    }
    if (grid < 0) return;
    Args a{};
    for (int i = 0; i < 21; ++i) a.in[i] = (const float*)d_in[i];
    a.out = (float*)d_out; a.ws = (unsigned char*)d_ws;
#if MK_COOP
    if (hipMemsetAsync(d_ws, 0, CTL_ZERO_BYTES, stream) != hipSuccess) { fprintf(stderr, "kernel_launch: memset failed\n"); return; }
    a.ph_lo = 0; a.ph_hi = N_PHASES;
    void* args[] = {&a};
    hipError_t e = hipLaunchCooperativeKernel((const void*)mk_fwd, dim3(grid), dim3(NTHREADS), args, LDS_BYTES, stream);
    if (e != hipSuccess) fprintf(stderr, "cooperative launch failed: %s (grid %d)\n", hipGetErrorString(e), grid);
#else
    for (int ph = 0; ph < N_PHASES; ++ph) {
        a.ph_lo = ph; a.ph_hi = ph + 1;
        hipLaunchKernelGGL(mk_fwd, dim3(grid), dim3(NTHREADS), LDS_BYTES, stream, a);
    }
#endif
}
```
